# Optimizing an MI355X kernel written in HIP

```python
import math
import jax
import jax.numpy as jnp
from jax import lax
import numpy as np

D_MODEL = 1024
BATCH = 8
SEQ = 2048
DEPTH = 2

GRID_W = 64
CTX_LEN = 256
EPS = 1e-6
ROPE_BASE = 10000.0
N_MOD = 9
N_MOD_CTX_LAST = 5
N_BRANCH = 4
BRANCH_W = 512
FFN_HIDDEN = 2816

MLA_HEADS = 4
MLA_NOPE = 128
MLA_ROPE = 64
MLA_V = 128
MLA_Q_RANK = 256
MLA_KV_RANK = 256
MLA_BLOCK = 128
HY_W = 512
HY_EMB = 33
HY_FILT = 64
HY_SHORT = 3
HY_FAST_PCT = 0.3
HY_SLOW_PCT = 1.5
HY_TARGET = 1e-2
S5_W = 512
S5_H = 16
S5_G = S5_W // S5_H
S5_P = 64
NA_HEADS = 8
NA_DIM = 64
NA_WIN_R = 8
NA_WIN_C = 16

IN_SPLITS = (MLA_KV_RANK, MLA_ROPE, NA_HEADS * NA_DIM, NA_HEADS * NA_DIM, S5_W,
             MLA_Q_RANK, NA_HEADS * NA_DIM, 3 * HY_W, N_BRANCH * D_MODEL)
N_KV_SIDE = 5
N_IN = sum(IN_SPLITS)
N_CTX_COLS = sum(IN_SPLITS[:N_KV_SIDE])

kernel_name = 'hybrid_mla_hyena_s5_natten_block'


def rms_norm(x, g):
    xf = x.astype(jnp.float32)
    y = xf * lax.rsqrt(jnp.mean(xf * xf, axis=-1, keepdims=True) + EPS)
    return (y * g.astype(jnp.float32)).astype(x.dtype)


def split_cols(z, sizes):
    return jnp.split(z, np.cumsum(sizes)[:-1].tolist(), axis=-1)


def modulated_norm(x, g, shift, scale):
    return rms_norm(x, g) * (1 + scale) + shift


def swiglu(h, w_in, w_out):
    a, b = jnp.split(h @ w_in, 2, axis=-1)
    return (jax.nn.silu(a) * b) @ w_out


def ffn_sublayer(x, mods, base, g_pre, g_post, w_in, w_out):
    h = modulated_norm(x, g_pre, mods[base], mods[base + 1])
    return x + 0.5 * mods[base + 2] * rms_norm(swiglu(h, w_in, w_out), g_post)


def axial_rope(x):
    n_tok, r = x.shape[1], x.shape[-1]
    q = r // 4
    t = jnp.arange(n_tok)
    pos = jnp.stack([t // GRID_W, t % GRID_W], axis=-1).astype(jnp.float32)
    inv = ROPE_BASE ** (-jnp.arange(q, dtype=jnp.float32) / q)
    ang = pos[:, :, None] * inv
    cos, sin = jnp.cos(ang)[:, None], jnp.sin(ang)[:, None]
    xr = x.astype(jnp.float32).reshape(x.shape[:-1] + (2, 2, q))
    x1, x2 = xr[..., 0, :], xr[..., 1, :]
    out = jnp.stack([x1 * cos - x2 * sin, x2 * cos + x1 * sin], axis=-2)
    return out.reshape(x.shape).astype(x.dtype)


def attend(q, k, v, scale):
    s = jnp.einsum('bqhe,bkhe->bhqk', q, k, preferred_element_type=jnp.float32) * scale
    p = jax.nn.softmax(s, axis=-1).astype(v.dtype)
    return jnp.einsum('bhqk,bkhe->bqhe', p, v)


def blocked_attention(q, k, v, scale):
    b, n_tok, h, e = q.shape
    nb = n_tok // MLA_BLOCK
    qb = q.reshape(b, nb, MLA_BLOCK, h, e).transpose(1, 0, 2, 3, 4)
    ob = lax.map(lambda qq: attend(qq, k, v, scale), qb)
    return ob.transpose(1, 0, 2, 3, 4).reshape(b, n_tok, h * v.shape[-1])


def mla_q(c_q, g_q, w_uq, rope):
    q = jnp.einsum('blr,rhe->blhe', rms_norm(c_q, g_q), w_uq)
    if not rope:
        return q
    return jnp.concatenate([q[..., :MLA_NOPE], axial_rope(q[..., MLA_NOPE:])], axis=-1)


def mla_kv(c_kv, k_rope, g_kv, w_ukv, rope):
    kv = jnp.einsum('blr,rhe->blhe', rms_norm(c_kv, g_kv), w_ukv)
    kr = k_rope[:, :, None, :]
    if rope:
        kr = axial_rope(kr)
    kr = jnp.broadcast_to(kr, kv.shape[:3] + (MLA_ROPE,))
    return jnp.concatenate([kv[..., :MLA_NOPE], kr], axis=-1), kv[..., MLA_NOPE:]


def neighbourhood_attention(q, k, v, k_c, v_c, rpb):
    b, n_tok, h, e = q.shape
    rows = n_tok // GRID_W
    kr = min(NA_WIN_R, rows)
    r = jnp.arange(rows)
    row_idx = jnp.clip(r - kr // 2, 0, rows - kr)[:, None] + jnp.arange(kr)
    col = jnp.arange(GRID_W)
    c0 = jnp.clip(col - NA_WIN_C // 2, 0, GRID_W - NA_WIN_C)
    in_win = (col[None, :] >= c0[:, None]) & (col[None, :] < c0[:, None] + NA_WIN_C)
    dr = row_idx - r[:, None] + NA_WIN_R - 1
    dc = jnp.clip(col[None, :] - col[:, None] + NA_WIN_C - 1, 0, 2 * NA_WIN_C - 2)
    bias = rpb[:, dr[:, None, :, None], dc[None, :, None, :]].astype(jnp.float32)
    bias = jnp.where(in_win[None, None, :, None, :], bias, -jnp.inf).reshape(h, rows, GRID_W, kr * GRID_W)
    qg = q.reshape(b, rows, GRID_W, h, e)
    kg = k.reshape(b, rows, GRID_W, h, e)[:, row_idx].reshape(b, rows, kr * GRID_W, h, e)
    vg = v.reshape(b, rows, GRID_W, h, e)[:, row_idx].reshape(b, rows, kr * GRID_W, h, e)
    scale = e ** -0.5
    s_ctx = jnp.einsum('brqhe,bkhe->bhrqk', qg, k_c, preferred_element_type=jnp.float32) * scale
    s_loc = jnp.einsum('brqhe,brkhe->bhrqk', qg, kg, preferred_element_type=jnp.float32) * scale + bias
    p = jax.nn.softmax(jnp.concatenate([s_ctx, s_loc], axis=-1), axis=-1).astype(v.dtype)
    n_c = k_c.shape[1]
    o = (jnp.einsum('bhrqk,bkhe->brqhe', p[..., :n_c], v_c)
         + jnp.einsum('bhrqk,brkhe->brqhe', p[..., n_c:], vg))
    return o.reshape(b, n_tok, h * e)


def hyena_filters(n_tok, w1, b1, f1, w2, b2, f2, w3):
    bands = (HY_EMB - 1) // 2
    t = jnp.arange(n_tok, dtype=jnp.float32)
    t01 = jnp.linspace(0.0, 1.0, n_tok, dtype=jnp.float32)[:, None]
    ang = (2.0 * math.pi * t / n_tok)[:, None] * jnp.linspace(1e-4, bands - 1, bands, dtype=jnp.float32)
    z = jnp.concatenate([t01, jnp.cos(ang), -jnp.sin(ang)], axis=-1)
    hf = jnp.sin(f1 * (z @ w1 + b1))
    hf = jnp.sin(f2 * (hf @ w2 + b2))
    hf = (hf @ w3).astype(jnp.float32)
    max_decay = math.log(HY_TARGET) / HY_FAST_PCT
    min_decay = math.log(HY_TARGET) / HY_SLOW_PCT
    deltas = jnp.abs(jnp.linspace(min_decay, max_decay, HY_W, dtype=jnp.float32))
    decay = jnp.exp(-t01 * deltas)
    return hf * jnp.concatenate([decay, decay], axis=-1)


def hyena_stream(z, conv_w, conv_b, bias_d, filt):
    b, n_tok, ch = z.shape
    pad = HY_SHORT // 2
    u = lax.conv_general_dilated(z, conv_w[:, None, :], (1,), [(pad, HY_SHORT - 1 - pad)],
                                 dimension_numbers=('NWC', 'WIO', 'NWC'), feature_group_count=ch) + conv_b
    v, x1, x0 = jnp.split(u, 3, axis=-1)
    s = (v * x1).astype(jnp.float32)
    n_fft = 2 * n_tok
    spec_h = (jnp.fft.rfft(filt[:, :HY_W], n=n_fft, axis=0)
              + jnp.conj(jnp.fft.rfft(filt[:, HY_W:], n=n_fft, axis=0)))
    y = jnp.fft.irfft(jnp.fft.rfft(s, n=n_fft, axis=1) * spec_h, n=n_fft, axis=1)[:, :n_tok]
    y = y + s * bias_d.astype(jnp.float32)
    return (x0.astype(jnp.float32) * y).astype(z.dtype)


def s5_discretize(lam_re, lam_im, log_dt, b_re, b_im):
    lam = lax.complex(jnp.minimum(lam_re.astype(jnp.float32), -1e-4), lam_im.astype(jnp.float32))
    lam_dt = lam * jnp.exp(log_dt.astype(jnp.float32))[..., None]
    lam_bar = jnp.exp(lam_dt)
    b_bar = ((lam_bar - 1.0) / lam)[..., None] * lax.complex(b_re.astype(jnp.float32), b_im.astype(jnp.float32))
    return lam_dt, lam_bar, b_bar


def _lin_combine(e1, e2):
    a1, b1 = e1
    a2, b2 = e2
    return a1 * a2, a2 * b1 + b2


def s5_scan(u, lam_dt, lam_bar, b_bar, s0, reverse):
    bu = jnp.einsum('blgh,gph->blgp', u.astype(jnp.float32).astype(jnp.complex64), b_bar)
    a = jnp.broadcast_to(lam_bar, bu.shape)
    _, xs = lax.associative_scan(_lin_combine, (a, bu), reverse=reverse, axis=1)
    if s0 is not None:
        n_tok = u.shape[1]
        steps = (n_tok - jnp.arange(n_tok) if reverse else jnp.arange(n_tok) + 1).astype(jnp.float32)
        xs = xs + jnp.exp(lam_dt * steps[:, None, None])[None] * s0[:, None]
    return xs


def s5_readout(u, xf, xb, c_re, c_im, d, w_glu, b_glu):
    cm = lax.complex(c_re.astype(jnp.float32), c_im.astype(jnp.float32))
    y = jnp.real(jnp.einsum('blgp,ghp->blgh', xf, cm[0]) + jnp.einsum('blgp,ghp->blgh', xb, cm[1]))
    b, n_tok = u.shape[:2]
    y = y.reshape(b, n_tok, S5_W) + d.astype(jnp.float32) * u.reshape(b, n_tok, S5_W).astype(jnp.float32)
    g = jax.nn.gelu(y).astype(u.dtype)
    ga, gb = jnp.split(g @ w_glu + b_glu, 2, axis=-1)
    return ga * jax.nn.sigmoid(gb)


def merge_branches(branches, gate_pre, w_branch, w_out):
    b, n_tok, _ = gate_pre.shape
    g = jax.nn.sigmoid(gate_pre.reshape(b, n_tok, N_BRANCH, D_MODEL))
    proj = jnp.einsum('blnw,nwd->blnd', jnp.stack(branches, axis=2), w_branch)
    return jnp.sum(g * proj, axis=2) @ w_out


def token_mixer(hc, hl, p, ctx_out):
    b, n_lat, _ = hl.shape
    n_ctx = hc.shape[1]
    zl = split_cols(hl @ p['w_in'], IN_SPLITS)
    if ctx_out:
        zc = split_cols(hc @ p['w_in'], IN_SPLITS)
    else:
        zc = split_cols(hc @ p['w_in'][:, :N_CTX_COLS], IN_SPLITS[:N_KV_SIDE])
    ckv_l, kr_l, nk_l, nv_l, u_l, cq_l, nq_l, hy_l, gt_l = zl
    ckv_c, kr_c, nk_c, nv_c, u_c = zc[:N_KV_SIDE]
    heads = lambda t, n: t.reshape(t.shape[:2] + (n, -1))

    mla_scale = (MLA_NOPE + MLA_ROPE) ** -0.5
    k_c, v_c = mla_kv(ckv_c, kr_c, p['mla_g_kv'], p['mla_w_ukv'], False)
    k_l, v_l = mla_kv(ckv_l, kr_l, p['mla_g_kv'], p['mla_w_ukv'], True)
    q_l = mla_q(cq_l, p['mla_g_q'], p['mla_w_uq'], True)
    a_l = blocked_attention(q_l, jnp.concatenate([k_c, k_l], axis=1),
                            jnp.concatenate([v_c, v_l], axis=1), mla_scale)

    hyp = (p['hy_w1'], p['hy_b1'], p['hy_freq1'], p['hy_w2'], p['hy_b2'], p['hy_freq2'], p['hy_w3'])
    b_l = hyena_stream(hy_l, p['hy_conv_w'], p['hy_conv_b'], p['hy_bias'], hyena_filters(n_lat, *hyp))

    lam_dt, lam_bar, b_bar = s5_discretize(p['s5_lam_re'], p['s5_lam_im'], p['s5_log_dt'],
                                           p['s5_b_re'], p['s5_b_im'])
    uc = u_c.reshape(b, n_ctx, S5_G, S5_H)
    ul = u_l.reshape(b, n_lat, S5_G, S5_H)
    xf_c = s5_scan(uc, lam_dt[0], lam_bar[0], b_bar[0], None, False)
    xb_c = s5_scan(uc, lam_dt[1], lam_bar[1], b_bar[1], None, True)
    xf_l = s5_scan(ul, lam_dt[0], lam_bar[0], b_bar[0], xf_c[:, -1], False)
    xb_l = s5_scan(ul, lam_dt[1], lam_bar[1], b_bar[1], xb_c[:, 0], True)
    s5p = (p['s5_c_re'], p['s5_c_im'], p['s5_d'], p['s5_w_glu'], p['s5_b_glu'])
    c_l = s5_readout(ul, xf_l, xb_l, *s5p)

    nk_c, nv_c = heads(nk_c, NA_HEADS), heads(nv_c, NA_HEADS)
    d_l = neighbourhood_attention(heads(nq_l, NA_HEADS), heads(nk_l, NA_HEADS), heads(nv_l, NA_HEADS),
                                  nk_c, nv_c, p['na_rpb'])

    y_l = merge_branches([a_l, b_l, c_l, d_l], gt_l, p['w_branch'], p['w_out'])
    if not ctx_out:
        return None, y_l

    cq_c, nq_c, hy_c, gt_c = zc[N_KV_SIDE:]
    a_c = attend(mla_q(cq_c, p['mla_g_q'], p['mla_w_uq'], False), k_c, v_c, mla_scale).reshape(b, n_ctx, -1)
    b_c = hyena_stream(hy_c, p['hy_conv_w'], p['hy_conv_b'], p['hy_bias'], hyena_filters(n_ctx, *hyp))
    c_c = s5_readout(uc, xf_c, xb_c, *s5p)
    d_c = attend(heads(nq_c, NA_HEADS), nk_c, nv_c, NA_DIM ** -0.5).reshape(b, n_ctx, -1)
    y_c = merge_branches([a_c, b_c, c_c, d_c], gt_c, p['w_branch'], p['w_out'])
    return y_c, y_l


def hybrid_layer(xc, xl, mod_c, mod_l, p, ctx_out):
    g = p['norm_g']
    mc = jnp.split(mod_c, mod_c.shape[-1] // D_MODEL, axis=-1)
    ml = jnp.split(mod_l, N_MOD, axis=-1)
    fi, fo = p['ffn_w_in'], p['ffn_w_out']
    xl = ffn_sublayer(xl, ml, 0, g[0], g[1], fi[0], fo[0])
    xc = ffn_sublayer(xc, mc, 0, g[0], g[1], fi[0], fo[0])
    hl = modulated_norm(xl, g[2], ml[3], ml[4])
    hc = modulated_norm(xc, g[2], mc[3], mc[4])
    yc, yl = token_mixer(hc, hl, p, ctx_out)
    xl = xl + ml[5] * rms_norm(yl, g[3])
    xl = ffn_sublayer(xl, ml, 6, g[4], g[5], fi[1], fo[1])
    if not ctx_out:
        return None, xl
    xc = xc + mc[5] * rms_norm(yc, g[3])
    xc = ffn_sublayer(xc, mc, 6, g[4], g[5], fi[1], fo[1])
    return xc, xl


def setup_inputs(seed: int = 0) -> dict:
    key = jax.random.key(seed)
    ks = iter(jax.random.split(key, 48))
    nrm = lambda shape, scale: jax.random.normal(next(ks), shape, jnp.float32) * scale
    gain = lambda shape, s=0.05: 1.0 + nrm(shape, s)
    d, nl, f = D_MODEL, DEPTH, FFN_HIDDEN
    n_idx = jnp.arange(S5_P, dtype=jnp.float32)
    return {
        'x': nrm((BATCH, SEQ, d), 1.0),
        'c': nrm((BATCH, d), 1.0),
        'ctx': nrm((BATCH, CTX_LEN, d), 1.0),
        'c_ctx': nrm((d,), 1.0),
        'w_mod': nrm((nl, d, N_MOD * d), 0.5 * d ** -0.5),
        'b_mod': nrm((nl, N_MOD * d), 0.01),
        'norm_g': gain((nl, 6, d)),
        'ffn_w_in': nrm((nl, 2, d, 2 * f), d ** -0.5),
        'ffn_w_out': nrm((nl, 2, f, d), f ** -0.5),
        'w_in': nrm((nl, d, N_IN), d ** -0.5),
        'mla_g_q': gain((nl, MLA_Q_RANK)),
        'mla_g_kv': gain((nl, MLA_KV_RANK)),
        'mla_w_uq': nrm((nl, MLA_Q_RANK, MLA_HEADS, MLA_NOPE + MLA_ROPE), MLA_Q_RANK ** -0.5),
        'mla_w_ukv': nrm((nl, MLA_KV_RANK, MLA_HEADS, MLA_NOPE + MLA_V), MLA_KV_RANK ** -0.5),
        'na_rpb': nrm((nl, NA_HEADS, 2 * NA_WIN_R - 1, 2 * NA_WIN_C - 1), 0.2),
        'hy_conv_w': nrm((nl, HY_SHORT, 3 * HY_W), HY_SHORT ** -0.5),
        'hy_conv_b': nrm((nl, 3 * HY_W), 0.01),
        'hy_bias': nrm((nl, HY_W), 0.5),
        'hy_w1': nrm((nl, HY_EMB, HY_FILT), HY_EMB ** -0.5),
        'hy_b1': nrm((nl, HY_FILT), 0.1),
        'hy_freq1': gain((nl, HY_FILT), 0.1),
        'hy_w2': nrm((nl, HY_FILT, HY_FILT), HY_FILT ** -0.5),
        'hy_b2': nrm((nl, HY_FILT), 0.1),
        'hy_freq2': gain((nl, HY_FILT), 0.1),
        'hy_w3': nrm((nl, HY_FILT, 2 * HY_W), 0.1 * HY_FILT ** -0.5),
        's5_lam_re': -0.5 + nrm((nl, 2, S5_G, S5_P), 0.01),
        's5_lam_im': math.pi * n_idx + nrm((nl, 2, S5_G, S5_P), 0.01),
        's5_log_dt': jax.random.uniform(next(ks), (nl, 2, S5_G), jnp.float32, math.log(1e-3), math.log(1e-1)),
        's5_b_re': nrm((nl, 2, S5_G, S5_P, S5_H), (2 * S5_H) ** -0.5),
        's5_b_im': nrm((nl, 2, S5_G, S5_P, S5_H), (2 * S5_H) ** -0.5),
        's5_c_re': nrm((nl, 2, S5_G, S5_H, S5_P), 2.0 * S5_P ** -0.5),
        's5_c_im': nrm((nl, 2, S5_G, S5_H, S5_P), 2.0 * S5_P ** -0.5),
        's5_d': nrm((nl, S5_W), 0.5),
        's5_w_glu': nrm((nl, S5_W, 2 * S5_W), S5_W ** -0.5),
        's5_b_glu': nrm((nl, 2 * S5_W), 0.01),
        'w_branch': nrm((nl, N_BRANCH, BRANCH_W, d), BRANCH_W ** -0.5),
        'w_out': nrm((nl, d, d), d ** -0.5),
    }


def reference(x, c, ctx, c_ctx, w_mod, b_mod, norm_g, ffn_w_in, ffn_w_out, w_in,
              mla_g_q, mla_g_kv, mla_w_uq, mla_w_ukv, na_rpb,
              hy_conv_w, hy_conv_b, hy_bias, hy_w1, hy_b1, hy_freq1, hy_w2, hy_b2, hy_freq2, hy_w3,
              s5_lam_re, s5_lam_im, s5_log_dt, s5_b_re, s5_b_im, s5_c_re, s5_c_im, s5_d, s5_w_glu, s5_b_glu,
              w_branch, w_out):
    act_l = jax.nn.silu(c)
    act_c = jax.nn.silu(c_ctx)
    xc, xl = ctx, x
    for i in range(DEPTH):
        ctx_out = i < DEPTH - 1
        n_c = (N_MOD if ctx_out else N_MOD_CTX_LAST) * D_MODEL
        mod_l = (act_l @ w_mod[i] + b_mod[i])[:, None, :]
        mod_c = (act_c @ w_mod[i][:, :n_c] + b_mod[i][:n_c])[None, None, :]
        p = {
            'norm_g': norm_g[i], 'ffn_w_in': ffn_w_in[i], 'ffn_w_out': ffn_w_out[i], 'w_in': w_in[i],
            'mla_g_q': mla_g_q[i], 'mla_g_kv': mla_g_kv[i], 'mla_w_uq': mla_w_uq[i], 'mla_w_ukv': mla_w_ukv[i],
            'na_rpb': na_rpb[i],
            'hy_conv_w': hy_conv_w[i], 'hy_conv_b': hy_conv_b[i], 'hy_bias': hy_bias[i],
            'hy_w1': hy_w1[i], 'hy_b1': hy_b1[i], 'hy_freq1': hy_freq1[i],
            'hy_w2': hy_w2[i], 'hy_b2': hy_b2[i], 'hy_freq2': hy_freq2[i], 'hy_w3': hy_w3[i],
            's5_lam_re': s5_lam_re[i], 's5_lam_im': s5_lam_im[i], 's5_log_dt': s5_log_dt[i],
            's5_b_re': s5_b_re[i], 's5_b_im': s5_b_im[i], 's5_c_re': s5_c_re[i], 's5_c_im': s5_c_im[i],
            's5_d': s5_d[i], 's5_w_glu': s5_w_glu[i], 's5_b_glu': s5_b_glu[i],
            'w_branch': w_branch[i], 'w_out': w_out[i],
        }
        xc, xl = hybrid_layer(xc, xl, mod_c, mod_l, p, ctx_out)
    return xl
```

```cpp
#define ONE_LAUNCH 1
#include <hip/hip_runtime.h>
#include <hip/hip_bf16.h>
#include <hip/hip_cooperative_groups.h>
#include <cstdio>
namespace cg = cooperative_groups;

typedef unsigned short u16;
using bf16x8 = __attribute__((ext_vector_type(8))) short;
using f32x4 = __attribute__((ext_vector_type(4))) float;
using f32x2 = __attribute__((ext_vector_type(2))) float;
using u32x4 = __attribute__((ext_vector_type(4))) unsigned int;

#define DEV __device__ __forceinline__

constexpr int D = 1024, NB = 8, SEQ = 2048, CTXL = 256;
constexpr int NL = NB * SEQ, NC = NB * CTXL, NT = NL + NC;
constexpr int FH = 2816, NIN = 8256, ZW = 4224;
constexpr int C_CKV = 0, C_KR = 256, C_NK = 320, C_NV = 832, C_U = 1344, C_CQ = 1856, C_NQ = 2112, C_HY = 2624, C_GATE = 4160;
constexpr int KEYS = 2304;
constexpr int NCH = 72;
constexpr int RKL = 4096, RKC = 512;
constexpr int RK_LAYER = 512 * RKL + 512 * RKC;
constexpr int SMEM_BYTES = 77824;
constexpr int SMEM_TOTAL = 2 * SMEM_BYTES + 16;
constexpr float EPS = 1e-6f;

constexpr size_t ws_au(size_t v) { return (v + 255) & ~(size_t)255; }
constexpr size_t OFF_BAR = 0;
constexpr size_t OFF_XC = ws_au(OFF_BAR + (size_t)3456 * 4);
constexpr size_t OFF_MODS = ws_au(OFF_XC + (size_t)NC * D * 4);
constexpr size_t OFF_S5P = ws_au(OFF_MODS + (size_t)2 * 9 * 9216 * 4);
constexpr size_t OFF_S5F = ws_au(OFF_S5P + (size_t)128 * 2304 * 4);
constexpr size_t OFF_S5PB = ws_au(OFF_S5F + (size_t)NB * 32 * 2 * NCH * 64 * 8);
constexpr size_t OFF_S5PC = ws_au(OFF_S5PB + (size_t)128 * 128 * 16 * 2);
constexpr size_t OFF_ROPE = ws_au(OFF_S5PC + (size_t)2 * 32 * 16 * 256 * 2);
constexpr size_t OFF_RK = ws_au(OFF_ROPE + (size_t)2048 * 32 * 8);
constexpr size_t OFF_H = ws_au(OFF_RK + (size_t)2 * RK_LAYER * 2);
constexpr size_t OFF_WM = ws_au(OFF_H + (size_t)NT * D * 2);
constexpr size_t OFF_R = ws_au(OFF_WM + (size_t)12582912 * 2);
constexpr size_t OFF_HID = OFF_R;
constexpr size_t OFF_Y = OFF_R + ws_au((size_t)NT * FH * 2);
constexpr size_t OFF_Z = OFF_R;
constexpr size_t OFF_Q = ws_au(OFF_Z + (size_t)NT * ZW * 2);
constexpr size_t OFF_KB = ws_au(OFF_Q + (size_t)NT * 768 * 2);
constexpr size_t OFF_VT = ws_au(OFF_KB + (size_t)NB * 4 * KEYS * 192 * 2);
constexpr size_t OFF_NVT = ws_au(OFF_VT + (size_t)NB * 4 * 128 * KEYS * 2);
constexpr size_t OFF_BRH = ws_au(OFF_NVT + (size_t)NB * 8 * 64 * KEYS * 2);
constexpr size_t OFF_ST = ws_au(OFF_BRH + (size_t)NT * 512 * 2);
constexpr size_t WS_TOTAL = ws_au(OFF_ST + (size_t)NB * 512 * KEYS * 2);

struct Params {
  const float *x, *c, *ctx, *c_ctx, *w_mod, *b_mod, *norm_g, *ffn_w_in, *ffn_w_out, *w_in, *mla_g_q, *mla_g_kv,
      *mla_w_uq, *mla_w_ukv, *na_rpb, *hy_conv_w, *hy_conv_b, *hy_bias, *hy_w1, *hy_b1, *hy_f1, *hy_w2, *hy_b2,
      *hy_f2, *hy_w3, *s5_lam_re, *s5_lam_im, *s5_log_dt, *s5_b_re, *s5_b_im, *s5_c_re, *s5_c_im, *s5_d, *s5_w_glu,
      *s5_b_glu, *w_branch, *w_out;
  float* out;
  unsigned char* ws;
  __device__ __forceinline__ unsigned* bar() const { return (unsigned*)(ws + OFF_BAR); }
  __device__ __forceinline__ float* xc() const { return (float*)(ws + OFF_XC); }
  __device__ __forceinline__ float* mods() const { return (float*)(ws + OFF_MODS); }
  __device__ __forceinline__ float* S5P() const { return (float*)(ws + OFF_S5P); }
  __device__ __forceinline__ float* S5F() const { return (float*)(ws + OFF_S5F); }
  __device__ __forceinline__ u16* S5PB() const { return (u16*)(ws + OFF_S5PB); }
  __device__ __forceinline__ u16* S5PC() const { return (u16*)(ws + OFF_S5PC); }
  __device__ __forceinline__ float2* ROPE() const { return (float2*)(ws + OFF_ROPE); }
  __device__ __forceinline__ u16* RK() const { return (u16*)(ws + OFF_RK); }
  __device__ __forceinline__ u16* H() const { return (u16*)(ws + OFF_H); }
  __device__ __forceinline__ u16* WM() const { return (u16*)(ws + OFF_WM); }
  __device__ __forceinline__ u16* HID() const { return (u16*)(ws + OFF_HID); }
  __device__ __forceinline__ float* Y() const { return (float*)(ws + OFF_Y); }
  __device__ __forceinline__ u16* Z() const { return (u16*)(ws + OFF_Z); }
  __device__ __forceinline__ u16* Q() const { return (u16*)(ws + OFF_Q); }
  __device__ __forceinline__ u16* Kb() const { return (u16*)(ws + OFF_KB); }
  __device__ __forceinline__ u16* VT() const { return (u16*)(ws + OFF_VT); }
  __device__ __forceinline__ u16* NVT() const { return (u16*)(ws + OFF_NVT); }
  __device__ __forceinline__ u16* BRH() const { return (u16*)(ws + OFF_BRH); }
  __device__ __forceinline__ u16* ST() const { return (u16*)(ws + OFF_ST); }
  __device__ __forceinline__ u16* M() const { return (u16*)(ws + OFF_KB); }
  __device__ __forceinline__ u16* WF() const { return (u16*)(ws + OFF_NVT); }
};

DEV int tidx512() { int t = threadIdx.x; asm volatile("" : "+v"(t)); return t; }
DEV int tidx() { int t = threadIdx.x & 255; asm volatile("" : "+v"(t)); return t; }
typedef __bf16 hwbf16x2 __attribute__((ext_vector_type(2)));
DEV u16 f2bf(float f) { return __builtin_bit_cast(u16, (__bf16)f); }
DEV float bf2f(u16 h) { return __uint_as_float(((unsigned)h) << 16); }
DEV unsigned pack2(float a, float b) {
  const hwbf16x2 r = __builtin_convertvector(f32x2{a, b}, hwbf16x2);
  return __builtin_bit_cast(unsigned, r);
}
DEV float bflo(unsigned u) { return __uint_as_float(u << 16); }
DEV float bfhi(unsigned u) { return __uint_as_float(u & 0xffff0000u); }
DEV float wave_sum(float v) {
#pragma unroll
  for (int o = 32; o > 0; o >>= 1) v += __shfl_xor(v, o);
  return v;
}
DEV float sigmoidf_(float x) { return __builtin_amdgcn_rcpf(1.f + __expf(-x)); }
DEV float siluf_(float x) { return x * __builtin_amdgcn_rcpf(1.f + __expf(-x)); }

template <int NI, bool HEADMAP>
DEV void gemm_core(f32x4 (&acc)[4][NI], const u16* __restrict__ A, int lda, const u16* __restrict__ Bt,
                          int ldk, int K, int baseLo, int baseHi, int stepW, u16* sm, u16*  ) {
  constexpr int BN = NI * 32, HS = BN / 4, LDK = 72;
  constexpr int NBC = BN / 32;
  constexpr int STAGE = (128 + BN) * LDK;
  const int tid = tidx(), lane = tid & 63, w = tid >> 6, wm = w >> 1, wn = w & 1, q = lane & 15, g = lane >> 4;
  const int ar = tid >> 3, akc = tid & 7;
  const u16* Ap = A + (size_t)ar * lda + akc * 8;
  auto browp = [&](int i) __attribute__((always_inline)) {
    const int bn = ar + 32 * i;
    const int bwn = bn / (BN / 2), br = bn % (BN / 2);
    const int grow = (br < HS ? baseLo : baseHi) + bwn * stepW + (br % HS);
    return Bt + (size_t)grow * ldk + akc * 8;
  };
  const u16* Bp0 = browp(0);
  const u16* Bp1 = browp(1);
  const u16* Bp2 = browp(NBC > 2 ? 2 : 0);
  const u16* Bp3 = browp(NBC > 2 ? 3 : 0);
  u32x4 r0a0, r0a1, r0a2, r0a3, r0b0, r0b1, r0b2, r0b3, r1a0, r1a1, r1a2, r1a3, r1b0, r1b1, r1b2, r1b3;
  r0b2 = r0b3 = r1b2 = r1b3 = u32x4{0, 0, 0, 0};
#define GLOAD(R, k0_)                                                                        \
  {                                                                                          \
    const int k0__ = (k0_);                                                                  \
    const int ka = HEADMAP ? ((k0__ >> 7) * 192 + (k0__ & 127)) : k0__;                      \
    R##a0 = *(const u32x4*)(Ap + ka);                                                         \
    R##a1 = *(const u32x4*)(Ap + (size_t)32 * lda + ka);                                      \
    R##a2 = *(const u32x4*)(Ap + (size_t)64 * lda + ka);                                      \
    R##a3 = *(const u32x4*)(Ap + (size_t)96 * lda + ka);                                      \
    R##b0 = *(const u32x4*)(Bp0 + k0__);                                                      \
    R##b1 = *(const u32x4*)(Bp1 + k0__);                                                      \
    if constexpr (NBC > 2) {                                                                 \
      R##b2 = *(const u32x4*)(Bp2 + k0__);                                                    \
      R##b3 = *(const u32x4*)(Bp3 + k0__);                                                    \
    }                                                                                        \
  }
#define LSTORE(R, st)                                                                        \
  {                                                                                          \
    u16* d__ = (st) + ar * LDK + akc * 8;                                                    \
    *(u32x4*)(d__) = R##a0;                                                                   \
    *(u32x4*)(d__ + 32 * LDK) = R##a1;                                                        \
    *(u32x4*)(d__ + 64 * LDK) = R##a2;                                                        \
    *(u32x4*)(d__ + 96 * LDK) = R##a3;                                                        \
    *(u32x4*)(d__ + 128 * LDK) = R##b0;                                                       \
    *(u32x4*)(d__ + 160 * LDK) = R##b1;                                                       \
    if constexpr (NBC > 2) {                                                                 \
      *(u32x4*)(d__ + 192 * LDK) = R##b2;                                                     \
      *(u32x4*)(d__ + 224 * LDK) = R##b3;                                                     \
    }                                                                                        \
  }
  auto compute = [&](const u16* sa) __attribute__((always_inline)) {
    const u16* sb = sa + 128 * LDK;
#pragma unroll
    for (int kk = 0; kk < 2; kk++) {
      bf16x8 af[4], bfr[NI];
#pragma unroll
      for (int mi = 0; mi < 4; mi++) af[mi] = *(const bf16x8*)(sa + (wm * 64 + mi * 16 + q) * LDK + kk * 32 + g * 8);
#pragma unroll
      for (int ni = 0; ni < NI; ni++) bfr[ni] = *(const bf16x8*)(sb + (wn * (BN / 2) + ni * 16 + q) * LDK + kk * 32 + g * 8);
#pragma unroll
      for (int mi = 0; mi < 4; mi++)
#pragma unroll
        for (int ni = 0; ni < NI; ni++)
          acc[mi][ni] = __builtin_amdgcn_mfma_f32_16x16x32_bf16(bfr[ni], af[mi], acc[mi][ni], 0, 0, 0);
    }
  };
  const int nk = K >> 6;
  u16* st0 = sm;
  u16* st1 = sm + STAGE;
  const int klast = K - 64;
  GLOAD(r0, 0);
  GLOAD(r1, min(64, klast));
  LSTORE(r0, st0);
  __syncthreads();
  for (int kt = 0; kt < nk; kt += 2) {
    if (kt + 2 < nk) GLOAD(r0, (kt + 2) << 6);
    compute(st0);
    LSTORE(r1, st1);
    __syncthreads();
    if (kt + 3 < nk) GLOAD(r1, (kt + 3) << 6);
    compute(st1);
    LSTORE(r0, st0);
    __syncthreads();
  }
#undef GLOAD
#undef LSTORE
}

DEV void gemm_core2(f32x4 (&acc)[8][4], const u16* __restrict__ A, int lda, const u16* __restrict__ Bt, int ldk, int K,
                    int baseLo, int baseHi, int stepW, u16* sm) {
  constexpr int LDK = 40, STAGE = 384 * LDK;
  const int tid = tidx(), lane = tid & 63, w = tid >> 6, wm = w >> 1, wn = w & 1, q = lane & 15, g = lane >> 4;
  const int ar = tid >> 2, akc = tid & 3;
  const u16* Ap = A + (size_t)ar * lda + akc * 8;
  const int br_ = ar & 63;
  const int growl = ((br_ & 32) ? baseHi : baseLo) + (br_ & 31);
  const u16* Bp0 = Bt + (size_t)growl * ldk + akc * 8;
  const u16* Bp1 = Bt + (size_t)(growl + stepW) * ldk + akc * 8;
  u32x4 r0a0, r0a1, r0a2, r0a3, r0b0, r0b1, r1a0, r1a1, r1a2, r1a3, r1b0, r1b1;
#define GLOAD2(R, k0_)                                            \
  {                                                               \
    const int k0__ = (k0_);                                       \
    R##a0 = *(const u32x4*)(Ap + k0__);                           \
    R##a1 = *(const u32x4*)(Ap + (size_t)64 * lda + k0__);        \
    R##a2 = *(const u32x4*)(Ap + (size_t)128 * lda + k0__);       \
    R##a3 = *(const u32x4*)(Ap + (size_t)192 * lda + k0__);       \
    R##b0 = *(const u32x4*)(Bp0 + k0__);                          \
    R##b1 = *(const u32x4*)(Bp1 + k0__);                          \
  }
#define LSTORE2(R, st)                                            \
  {                                                               \
    u16* d__ = (st) + ar * LDK + akc * 8;                         \
    *(u32x4*)(d__) = R##a0;                                       \
    *(u32x4*)(d__ + 64 * LDK) = R##a1;                            \
    *(u32x4*)(d__ + 128 * LDK) = R##a2;                           \
    *(u32x4*)(d__ + 192 * LDK) = R##a3;                           \
    *(u32x4*)(d__ + 256 * LDK) = R##b0;                           \
    *(u32x4*)(d__ + 320 * LDK) = R##b1;                           \
  }
  auto compute = [&](const u16* sa) __attribute__((always_inline)) {
    const u16* sb = sa + 256 * LDK;
    const u16* sap = sa + (wm * 128 + q) * LDK + g * 8;
    bf16x8 bfr[4];
#pragma unroll
    for (int ni = 0; ni < 4; ni++) bfr[ni] = *(const bf16x8*)(sb + (wn * 64 + ni * 16 + q) * LDK + g * 8);
    bf16x8 af[8];
    af[0] = *(const bf16x8*)(sap);
    af[1] = *(const bf16x8*)(sap + 16 * LDK);
    __builtin_amdgcn_sched_barrier(0);
#pragma unroll
    for (int mi = 0; mi < 8; mi++) {
      if (mi + 2 < 8) af[mi + 2] = *(const bf16x8*)(sap + (mi + 2) * 16 * LDK);
#pragma unroll
      for (int ni = 0; ni < 4; ni++)
        acc[mi][ni] = __builtin_amdgcn_mfma_f32_16x16x32_bf16(bfr[ni], af[mi], acc[mi][ni], 0, 0, 0);
      __builtin_amdgcn_sched_barrier(0);
    }
  };
  const int nk = K >> 5;
  u16* st0 = sm;
  u16* st1 = sm + STAGE;
  const int klast = K - 32;
  GLOAD2(r0, 0);
  GLOAD2(r1, min(32, klast));
  LSTORE2(r0, st0);
  __syncthreads();
  for (int kt = 0; kt < nk; kt += 2) {
    GLOAD2(r0, min((kt + 2) << 5, klast));
    __builtin_amdgcn_sched_barrier(0);
    compute(st0);
    LSTORE2(r1, st1);
    __syncthreads();
    GLOAD2(r1, min((kt + 3) << 5, klast));
    __builtin_amdgcn_sched_barrier(0);
    compute(st1);
    LSTORE2(r0, st0);
    __syncthreads();
  }
#undef GLOAD2
#undef LSTORE2
}

DEV void zero_acc8(f32x4 (&acc)[8][4]) {
#pragma unroll
  for (int mi = 0; mi < 8; mi++)
#pragma unroll
    for (int ni = 0; ni < 4; ni++) acc[mi][ni] = f32x4{0.f, 0.f, 0.f, 0.f};
}

DEV void wconv_tile(const float* __restrict__ src, int ldn, u16* __restrict__ dst, int K, int t,
                           unsigned char* smem) {
  u16* sT = (u16*)smem;
  const int tid = tidx();
  const int nkt = K >> 6;
  const int k0 = (t % nkt) * 64, n0 = (t / nkt) * 64;
  const int kr = tid >> 4, n4 = tid & 15;
  float4 v[4];
#pragma unroll
  for (int i = 0; i < 4; i++) v[i] = *(const float4*)(src + (size_t)(k0 + kr + 16 * i) * ldn + n0 + n4 * 4);
  __syncthreads();
#pragma unroll
  for (int i = 0; i < 4; i++) {
    const int k = kr + 16 * i;
    sT[(n4 * 4 + 0) * 72 + k] = f2bf(v[i].x);
    sT[(n4 * 4 + 1) * 72 + k] = f2bf(v[i].y);
    sT[(n4 * 4 + 2) * 72 + k] = f2bf(v[i].z);
    sT[(n4 * 4 + 3) * 72 + k] = f2bf(v[i].w);
  }
  __syncthreads();
#pragma unroll
  for (int j = 0; j < 2; j++) {
    const int c = tid + j * 256;
    const int n = c >> 3, kc = c & 7;
    *(uint4*)(dst + (size_t)(n0 + n) * K + k0 + kc * 8) = *(const uint4*)(sT + n * 72 + kc * 8);
  }
}

constexpr size_t WM_WIN = 0, WM_UQ = 8454144, WM_UKV = 8650752, WM_GLU = 8912896, WM_BR = 9437184, WM_OUT = 11534336,
                 WM_ELEMS = 12582912;
constexpr size_t WF_IN = 0, WF_OUT = 5767168, WF_ELEMS = 8650752;
constexpr int WM_TILES = 3072, WF_TILES = 2112;

DEV void wconv_mixer(const Params& p, int layer, int t, unsigned char* smem) {
  if (t < 2064) { wconv_tile(p.w_in + (size_t)layer * 1024 * NIN, NIN, p.WM() + WM_WIN, 1024, t, smem); return; }
  t -= 2064;
  if (t < 48) { wconv_tile(p.mla_w_uq + (size_t)layer * 256 * 768, 768, p.WM() + WM_UQ, 256, t, smem); return; }
  t -= 48;
  if (t < 64) { wconv_tile(p.mla_w_ukv + (size_t)layer * 256 * 1024, 1024, p.WM() + WM_UKV, 256, t, smem); return; }
  t -= 64;
  if (t < 128) { wconv_tile(p.s5_w_glu + (size_t)layer * 512 * 1024, 1024, p.WM() + WM_GLU, 512, t, smem); return; }
  t -= 128;
  if (t < 512) {
    const int n = t >> 7;
    wconv_tile(p.w_branch + ((size_t)layer * 4 + n) * 512 * 1024, 1024, p.WM() + WM_BR + (size_t)n * 1024 * 512, 512, t & 127, smem);
    return;
  }
  t -= 512;
  wconv_tile(p.w_out + (size_t)layer * D * D, D, p.WM() + WM_OUT, 1024, t, smem);
}
DEV void wconv_ffn(const Params& p, int layer, int which, int t, unsigned char* smem) {
  u16* dst = p.WF() + (size_t)which * WF_ELEMS;
  if (t < 1408) wconv_tile(p.ffn_w_in + ((size_t)layer * 2 + which) * 1024 * 5632, 5632, dst + WF_IN, 1024, t, smem);
  else wconv_tile(p.ffn_w_out + ((size_t)layer * 2 + which) * FH * D, D, dst + WF_OUT, FH, t - 1408, smem);
}

template <int NI>
DEV void zero_acc(f32x4 (&acc)[4][NI]) {
#pragma unroll
  for (int mi = 0; mi < 4; mi++)
#pragma unroll
    for (int ni = 0; ni < NI; ni++) acc[mi][ni] = f32x4{0.f, 0.f, 0.f, 0.f};
}

DEV void row_bk(int r, int& b, int& key) {
  if (r < NL) {
    b = r >> 11;
    key = 256 + (r & 2047);
  } else {
    int rr = r - NL;
    b = rr >> 8;
    key = rr & 255;
  }
}
DEV float* xrow_ptr(const Params& p, int r) { return r < NL ? p.out + (size_t)r * D : p.xc() + (size_t)(r - NL) * D; }
DEV const float* mod_ptr(const Params& p, int layer, int r) {
  int m = r < NL ? (r >> 11) : 8;
  return p.mods() + ((size_t)layer * 9 + m) * 9216;
}

DEV void mods_task(const Params& p, int task, unsigned char* smem) {
  float* sAct = (float*)smem;
  float* sRed = sAct + 9 * 1024;
  const int layer = task / 144, cb = task % 144;
  const int tid = tidx();
  __syncthreads();
  for (int i = tid; i < 9 * 1024; i += 256) {
    int r = i >> 10, k = i & 1023;
    float v = r < 8 ? p.c[r * 1024 + k] : p.c_ctx[k];
    sAct[i] = siluf_(v);
  }
  __syncthreads();
  const int col = cb * 64 + (tid & 63), kg = tid >> 6;
  const float* W = p.w_mod + (size_t)layer * 1024 * 9216 + col;
  float acc[9];
#pragma unroll
  for (int r = 0; r < 9; r++) acc[r] = 0.f;
#pragma unroll 1
  for (int k = kg * 256; k < kg * 256 + 256; k += 32) {
    float wv[32];
#pragma unroll
    for (int j = 0; j < 32; j++) wv[j] = W[(size_t)(k + j) * 9216];
#pragma unroll
    for (int j = 0; j < 32; j++)
#pragma unroll
      for (int r = 0; r < 9; r++) acc[r] += sAct[r * 1024 + k + j] * wv[j];
  }
#pragma unroll
  for (int r = 0; r < 9; r++) sRed[(kg * 9 + r) * 64 + (tid & 63)] = acc[r];
  __syncthreads();
  for (int i = tid; i < 9 * 64; i += 256) {
    int r = i >> 6, cc = i & 63;
    float s = sRed[(0 * 9 + r) * 64 + cc] + sRed[(1 * 9 + r) * 64 + cc] + sRed[(2 * 9 + r) * 64 + cc] +
              sRed[(3 * 9 + r) * 64 + cc];
    int gc = cb * 64 + cc;
    p.mods()[((size_t)layer * 9 + r) * 9216 + gc] = s + p.b_mod[layer * 9216 + gc];
  }
}

DEV void rope_task(const Params& p, int task) {
  const int idx = task * 256 + tidx();
  const int t = idx >> 5, e = idx & 31;
  const float pos = (e & 16) ? (float)(t & 63) : (float)(t >> 6);
  const float inv = expf(-(float)(e & 15) * (9.210340371976184f / 16.f));
  float sn, cs;
  sincosf(pos * inv, &sn, &cs);
  p.ROPE()[idx] = make_float2(cs, sn);
}

DEV void s5pre_task(const Params& p, int task) {
  const int idx = task * 256 + tidx();
  const int pp = idx & 63, ldg = idx >> 6;
  float re = fminf(p.s5_lam_re[idx], -1e-4f), im = p.s5_lam_im[idx];
  float dt = expf(p.s5_log_dt[ldg]);
  float er = expf(re * dt), sn, cs;
  sincosf(im * dt, &sn, &cs);
  float lbr = er * cs, lbi = er * sn;
  float e32 = expf(32.f * re * dt), sn32, cs32;
  sincosf(32.f * im * dt, &sn32, &cs32);
  float nr = lbr - 1.f, ni = lbi, den = re * re + im * im;
  float qr = (nr * re + ni * im) / den, qi = (ni * re - nr * im) / den;
  float* o = p.S5P() + (size_t)ldg * 2304 + pp;
  o[0 * 64] = lbr;
  o[1 * 64] = lbi;
  o[2 * 64] = e32 * cs32;
  o[3 * 64] = e32 * sn32;
  const float* bre = p.s5_b_re + (size_t)idx * 16;
  const float* bim = p.s5_b_im + (size_t)idx * 16;
  {
    const int lyr = ldg >> 6, dirr = (ldg >> 5) & 1, gg_ = ldg & 31;
    const float* cre = p.s5_c_re + (size_t)ldg * 16 * 64 + pp;
    const float* cim = p.s5_c_im + (size_t)ldg * 16 * 64 + pp;
    u16* tc = p.S5PC() + ((size_t)(lyr * 32 + gg_) * 16) * 256 + dirr * 128 + pp;
    for (int h = 0; h < 16; h++) {
      tc[h * 256] = f2bf(cre[h * 64]);
      tc[h * 256 + 64] = f2bf(-cim[h * 64]);
    }
  }
  u16* tb_re = p.S5PB() + ((size_t)ldg * 128 + pp) * 16;
  u16* tb_im = p.S5PB() + ((size_t)ldg * 128 + 64 + pp) * 16;
  for (int h = 0; h < 16; h++) {
    float br = bre[h], bi = bim[h];
    const float vr = qr * br - qi * bi, vi = qr * bi + qi * br;
    o[(4 + h * 2) * 64] = vr;
    o[(5 + h * 2) * 64] = vi;
    tb_re[h] = f2bf(vr);
    tb_im[h] = f2bf(vi);
  }
}

DEV void hyfilt_task(const Params& p, int task, unsigned char* smem) {
  float* sz = (float*)smem;
  float* h1 = sz + 8 * 33;
  float* h2 = h1 + 8 * 64;
  const int layer = task / 288, tb = task % 288;
  const bool isctx = tb >= 256;
  const int L = isctx ? CTXL : SEQ;
  const int t0 = (isctx ? tb - 256 : tb) * 8;
  const int tid = tidx();
  __syncthreads();
  for (int i = tid; i < 8 * 33; i += 256) {
    int tl = i / 33, e = i % 33;
    float t = (float)(t0 + tl);
    float v;
    if (e == 0) v = t / (float)(L - 1);
    else {
      int bi = (e - 1) & 15;
      float band = 1e-4f + (float)bi * ((15.f - 1e-4f) / 15.f);
      float ang = (2.0f * 3.14159265358979323846f * t / (float)L) * band;
      v = (e <= 16) ? cosf(ang) : -sinf(ang);
    }
    sz[i] = v;
  }
  __syncthreads();
  const float* w1 = p.hy_w1 + layer * 33 * 64;
  for (int i = tid; i < 8 * 64; i += 256) {
    int tl = i >> 6, j = i & 63;
    float s = p.hy_b1[layer * 64 + j];
    for (int e = 0; e < 33; e++) s += sz[tl * 33 + e] * w1[e * 64 + j];
    h1[i] = sinf(p.hy_f1[layer * 64 + j] * s);
  }
  __syncthreads();
  const float* w2 = p.hy_w2 + layer * 64 * 64;
  for (int i = tid; i < 8 * 64; i += 256) {
    int tl = i >> 6, j = i & 63;
    float s = p.hy_b2[layer * 64 + j];
    for (int e = 0; e < 64; e++) s += h1[tl * 64 + e] * w2[e * 64 + j];
    h2[i] = sinf(p.hy_f2[layer * 64 + j] * s);
  }
  __syncthreads();
  const float* w3 = p.hy_w3 + (size_t)layer * 64 * 1024;
  const float max_decay = logf(1e-2f) / 0.3f, min_decay = logf(1e-2f) / 1.5f;
  u16* RKb = p.RK() + (size_t)layer * RK_LAYER + (isctx ? (size_t)512 * RKL : 0);
  const int RW = isctx ? RKC : RKL;
  const int Dm = L - 1;
  for (int cc = 0; cc < 2; cc++) {
    const int c = tid + cc * 256;
    float af[8], ab[8];
#pragma unroll
    for (int tl = 0; tl < 8; tl++) af[tl] = ab[tl] = 0.f;
    for (int e = 0; e < 64; e++) {
      float wf = w3[e * 1024 + c], wb = w3[e * 1024 + 512 + c];
#pragma unroll
      for (int tl = 0; tl < 8; tl++) {
        float hv = h2[tl * 64 + e];
        af[tl] += hv * wf;
        ab[tl] += hv * wb;
      }
    }
    float delta = fabsf(min_decay + (max_decay - min_decay) * ((float)c / 511.f));
    u16* rk = RKb + (size_t)c * RW;
#pragma unroll
    for (int tl = 0; tl < 8; tl++) {
      int t = t0 + tl;
      float t01 = (float)t / (float)(L - 1);
      float dec = expf(-t01 * delta);
      float vf = af[tl] * dec, vb = ab[tl] * dec;
      if (t == 0) {
        rk[Dm] = f2bf(vf + vb + p.hy_bias[layer * 512 + c]);
        rk[2 * L - 1] = 0;
      } else {
        rk[Dm - t] = f2bf(vf);
        rk[Dm + t] = f2bf(vb);
      }
    }
  }
}

DEV void write_h_row(const Params& p, int r, const float (&xv)[16], int layer, int gidx, int shift_c, int scale_c) {
  const int lane = tidx() & 63;
  float ss = 0.f;
#pragma unroll
  for (int i = 0; i < 16; i++) ss += xv[i] * xv[i];
  ss = wave_sum(ss);
  const float rstd = rsqrtf(ss * (1.f / 1024.f) + EPS);
  const float* gg = p.norm_g + ((size_t)layer * 6 + gidx) * 1024;
  const float* md = mod_ptr(p, layer, r);
#pragma unroll
  for (int k = 0; k < 4; k++) {
    const int c0 = k * 256 + lane * 4;
    float4 g4 = *(const float4*)(gg + c0);
    float4 sh = *(const float4*)(md + shift_c * 1024 + c0);
    float4 sc = *(const float4*)(md + scale_c * 1024 + c0);
    float h0 = xv[k * 4 + 0] * rstd * g4.x * (1.f + sc.x) + sh.x;
    float h1 = xv[k * 4 + 1] * rstd * g4.y * (1.f + sc.y) + sh.y;
    float h2 = xv[k * 4 + 2] * rstd * g4.z * (1.f + sc.z) + sh.z;
    float h3 = xv[k * 4 + 3] * rstd * g4.w * (1.f + sc.w) + sh.w;
    uint2 o;
    o.x = pack2(h0, h1);
    o.y = pack2(h2, h3);
    *(uint2*)(p.H() + (size_t)r * D + c0) = o;
  }
}

DEV void norm1_row(const Params& p, int r) {
  const int lane = tidx() & 63;
  const float* xr = xrow_ptr(p, r);
  float xv[16];
#pragma unroll
  for (int k = 0; k < 4; k++) {
    float4 v = *(const float4*)(xr + k * 256 + lane * 4);
    xv[k * 4 + 0] = v.x; xv[k * 4 + 1] = v.y; xv[k * 4 + 2] = v.z; xv[k * 4 + 3] = v.w;
  }
  write_h_row(p, r, xv, 0, 0, 0, 1);
}

DEV void resid_row(const Params& p, int r, int layer, float coef, int gate_c, int gpost, bool wh, int nlayer,
                          int gnext, int shift_c, int scale_c, bool dry = false) {
  const int lane = tidx() & 63;
  float* xr = xrow_ptr(p, r);
  const u16* yr = (const u16*)p.Y() + (size_t)r * D;
  float yv[16], xv[16];
  float ss = 0.f;
#pragma unroll
  for (int k = 0; k < 4; k++) {
    const uint2 v = *(const uint2*)(yr + k * 256 + lane * 4);
    const float y0 = bflo(v.x), y1 = bfhi(v.x), y2 = bflo(v.y), y3 = bfhi(v.y);
    yv[k * 4 + 0] = y0; yv[k * 4 + 1] = y1; yv[k * 4 + 2] = y2; yv[k * 4 + 3] = y3;
    ss += y0 * y0 + y1 * y1 + y2 * y2 + y3 * y3;
  }
  ss = wave_sum(ss);
  const float rstd = rsqrtf(ss * (1.f / 1024.f) + EPS);
  const float* gg = p.norm_g + ((size_t)layer * 6 + gpost) * 1024;
  const float* md = mod_ptr(p, layer, r);
#pragma unroll
  for (int k = 0; k < 4; k++) {
    const int c0 = k * 256 + lane * 4;
    float4 xx = *(const float4*)(xr + c0);
    float4 g4 = *(const float4*)(gg + c0);
    float4 gt = *(const float4*)(md + gate_c * 1024 + c0);
    xx.x += coef * gt.x * (yv[k * 4 + 0] * rstd * g4.x);
    xx.y += coef * gt.y * (yv[k * 4 + 1] * rstd * g4.y);
    xx.z += coef * gt.z * (yv[k * 4 + 2] * rstd * g4.z);
    xx.w += coef * gt.w * (yv[k * 4 + 3] * rstd * g4.w);
    if (!dry) *(float4*)(xr + c0) = xx;
    xv[k * 4 + 0] = xx.x; xv[k * 4 + 1] = xx.y; xv[k * 4 + 2] = xx.z; xv[k * 4 + 3] = xx.w;
  }
  if (wh && !dry) write_h_row(p, r, xv, nlayer, gnext, shift_c, scale_c);
}

DEV void ffn_in_tile(const Params& p, int layer, int which, int tile, int MT, unsigned char* smem) {
  const int mt = tile % MT, nt = tile / MT;
  const int m0 = mt * 256, j0 = nt * 64;
  f32x4 acc[8][4];
  zero_acc8(acc);
  const u16* W = p.WF() + (size_t)which * WF_ELEMS + WF_IN;
  gemm_core2(acc, p.H() + (size_t)m0 * D, D, W, 1024, 1024, j0, FH + j0, 32, (u16*)smem);
  const int lane = tidx() & 63, w = tidx() >> 6, wm = w >> 1, wn = w & 1, q = lane & 15, g = lane >> 4;
#pragma unroll
  for (int mi = 0; mi < 8; mi++) {
    const int tok = m0 + wm * 128 + mi * 16 + q;
#pragma unroll
    for (int ni = 0; ni < 2; ni++) {
      f32x4 a = acc[mi][ni], b = acc[mi][ni + 2];
      const int col = j0 + wn * 32 + ni * 16 + g * 4;
      uint2 o;
      o.x = pack2(siluf_(a[0]) * b[0], siluf_(a[1]) * b[1]);
      o.y = pack2(siluf_(a[2]) * b[2], siluf_(a[3]) * b[3]);
      *(uint2*)(p.HID() + (size_t)tok * FH + col) = o;
    }
  }
}

DEV void gemm_f32out_tile(const Params& p, const u16* A, int lda, const u16* W, int ldb, int K, int tile,
                                 int MT, unsigned char* smem) {
  const int mt = tile % MT, nt = tile / MT;
  const int m0 = mt * 256, n0 = nt * 128;
  f32x4 acc[8][4];
  zero_acc8(acc);
  gemm_core2(acc, A + (size_t)m0 * lda, lda, W, ldb, K, n0, n0 + 32, 64, (u16*)smem);
  const int lane = tidx() & 63, w = tidx() >> 6, wm = w >> 1, wn = w & 1, q = lane & 15, g = lane >> 4;
#pragma unroll
  for (int mi = 0; mi < 8; mi++) {
    const int tok = m0 + wm * 128 + mi * 16 + q;
#pragma unroll
    for (int ni = 0; ni < 4; ni++) {
      const int col = n0 + wn * 64 + ni * 16 + g * 4;
      f32x4 a = acc[mi][ni];
      *(float4*)(p.Y() + (size_t)tok * D + col) = make_float4(a[0], a[1], a[2], a[3]);
    }
  }
}

DEV void inproj_tile(const Params& p, int layer, int tile, int MT, unsigned char* smem) {
  const int mt = tile % MT, nt = tile / MT;
  const int m0 = mt * 256, n0 = nt * 128;
  f32x4 acc[8][4];
  zero_acc8(acc);
  const u16* W = p.WM() + WM_WIN;
  gemm_core2(acc, p.H() + (size_t)m0 * D, D, W, 1024, 1024, n0, n0 + 32, 64, (u16*)smem);
  const int lane = tidx() & 63, w = tidx() >> 6, wm = w >> 1, wn = w & 1, q = lane & 15, g = lane >> 4;
#pragma unroll
  for (int mi = 0; mi < 8; mi++) {
    const int tok = m0 + wm * 128 + mi * 16 + q;
    int b, key;
    row_bk(tok, b, key);
#pragma unroll
    for (int ni = 0; ni < 4; ni++) {
      const int col = n0 + wn * 64 + ni * 16 + g * 4;
      f32x4 a = acc[mi][ni];
      uint2 o;
      o.x = pack2(a[0], a[1]);
      o.y = pack2(a[2], a[3]);
      *(uint2*)(p.Z() + (size_t)tok * ZW + col) = o;
      if (col >= C_NV && col < C_U) {
        const int hh = (col - C_NV) >> 6, e = (col - C_NV) & 63;
        u16* dst = p.NVT() + ((size_t)(b * 8 + hh) * 64 + e) * KEYS + key;
        dst[0] = (u16)(o.x & 0xffff);
        dst[KEYS] = (u16)(o.x >> 16);
        dst[2 * KEYS] = (u16)(o.y & 0xffff);
        dst[3 * KEYS] = (u16)(o.y >> 16);
      }
    }
  }
}

DEV void kvup_tile(const Params& p, int layer, int tile, int MT, unsigned char* smem) {
  u16* sA = (u16*)smem;
  u16* sB = sA + 128 * 40;
  const int mt = tile % MT, nt = tile / MT;
  const int m0 = mt * 128, n0 = nt * 128;
  f32x4 acc[4][4];
  zero_acc<4>(acc);
  const u16* W = p.WM() + WM_UKV;
  gemm_core<4, false>(acc, p.Z() + (size_t)m0 * ZW + C_CKV, ZW, W, 256, 256, n0, n0 + 32, 64, sA, sB);
  const int lane = tidx() & 63, w = tidx() >> 6, wm = w >> 1, wn = w & 1, q = lane & 15, g = lane >> 4;
#pragma unroll
  for (int mi = 0; mi < 4; mi++) {
    const int tok = m0 + wm * 64 + mi * 16 + q;
    int b, key;
    row_bk(tok, b, key);
#pragma unroll
    for (int ni = 0; ni < 4; ni++) {
      const int col = n0 + wn * 64 + ni * 16 + g * 4;
      const int hh = col >> 8, e = col & 255;
      f32x4 a = acc[mi][ni];
      uint2 o;
      o.x = pack2(a[0], a[1]);
      o.y = pack2(a[2], a[3]);
      if (e < 128) {
        *(uint2*)(p.Kb() + ((size_t)(b * 4 + hh) * KEYS + key) * 192 + e) = o;
      } else {
        u16* dst = p.VT() + ((size_t)(b * 4 + hh) * 128 + (e - 128)) * KEYS + key;
        dst[0] = (u16)(o.x & 0xffff);
        dst[KEYS] = (u16)(o.x >> 16);
        dst[2 * KEYS] = (u16)(o.y & 0xffff);
        dst[3 * KEYS] = (u16)(o.y >> 16);
      }
    }
  }
}

DEV void qup_tile(const Params& p, int layer, int tile, int MT, unsigned char* smem) {
  u16* sA = (u16*)smem;
  u16* sB = sA + 128 * 40;
  const int mt = tile % MT, nt = tile / MT;
  const int m0 = mt * 128, n0 = nt * 128;
  f32x4 acc[4][4];
  zero_acc<4>(acc);
  const u16* W = p.WM() + WM_UQ;
  gemm_core<4, false>(acc, p.Z() + (size_t)m0 * ZW + C_CQ, ZW, W, 256, 256, n0, n0 + 32, 64, sA, sB);
  const int lane = tidx() & 63, w = tidx() >> 6, wm = w >> 1, wn = w & 1, q = lane & 15, g = lane >> 4;
  const int cb = n0 + wn * 64;
  const bool ropeblk = (cb % 192) == 128;
#pragma unroll
  for (int mi = 0; mi < 4; mi++) {
    const int tok = m0 + wm * 64 + mi * 16 + q;
    f32x4 a0 = acc[mi][0], a1 = acc[mi][1], a2 = acc[mi][2], a3 = acc[mi][3];
    if (ropeblk && tok < NL) {
      const float2* rt = p.ROPE() + (size_t)(tok & 2047) * 32 + g * 4;
#pragma unroll
      for (int j = 0; j < 4; j++) {
        const float2 rr = rt[j], rc = rt[16 + j];
        float x1 = a0[j], x2 = a1[j];
        a0[j] = x1 * rr.x - x2 * rr.y;
        a1[j] = x2 * rr.x + x1 * rr.y;
        x1 = a2[j]; x2 = a3[j];
        a2[j] = x1 * rc.x - x2 * rc.y;
        a3[j] = x2 * rc.x + x1 * rc.y;
      }
    }
    u16* dst = p.Q() + (size_t)tok * 768 + cb + g * 4;
    uint2 o;
    o.x = pack2(a0[0], a0[1]); o.y = pack2(a0[2], a0[3]);
    *(uint2*)(dst) = o;
    o.x = pack2(a1[0], a1[1]); o.y = pack2(a1[2], a1[3]);
    *(uint2*)(dst + 16) = o;
    o.x = pack2(a2[0], a2[1]); o.y = pack2(a2[2], a2[3]);
    *(uint2*)(dst + 32) = o;
    o.x = pack2(a3[0], a3[1]); o.y = pack2(a3[2], a3[3]);
    *(uint2*)(dst + 48) = o;
  }
}

DEV void glu_tile(const Params& p, int layer, int tile, int MT, unsigned char* smem) {
  u16* sA = (u16*)smem;
  u16* sB = sA + 128 * 40;
  const int mt = tile % MT, nt = tile / MT;
  const int m0 = mt * 128, j0 = nt * 64;
  f32x4 acc[4][4];
  zero_acc<4>(acc);
  const u16* W = p.WM() + WM_GLU;
  gemm_core<4, false>(acc, p.Z() + (size_t)m0 * ZW + C_U, ZW, W, 512, 512, j0, 512 + j0, 32, sA, sB);
  const int lane = tidx() & 63, w = tidx() >> 6, wm = w >> 1, wn = w & 1, q = lane & 15, g = lane >> 4;
  const float* bg = p.s5_b_glu + layer * 1024;
#pragma unroll
  for (int mi = 0; mi < 4; mi++) {
    const int tok = m0 + wm * 64 + mi * 16 + q;
#pragma unroll
    for (int ni = 0; ni < 2; ni++) {
      f32x4 a = acc[mi][ni], b = acc[mi][ni + 2];
      const int col = j0 + wn * 32 + ni * 16 + g * 4;
      float r[4];
#pragma unroll
      for (int j = 0; j < 4; j++) r[j] = (a[j] + bg[col + j]) * sigmoidf_(b[j] + bg[512 + col + j]);
      uint2 o;
      o.x = pack2(r[0], r[1]);
      o.y = pack2(r[2], r[3]);
      *(uint2*)(p.Z() + (size_t)tok * ZW + C_HY + col) = o;
    }
  }
}

DEV unsigned char* gate_ptr(const Params& p, int n, int tok) {
  if (n == 0) return (unsigned char*)p.NVT() + (size_t)tok * 1024;
  if (n == 1) return (unsigned char*)p.ST() + (size_t)tok * 1024;
  if (n == 2) return (unsigned char*)p.S5F() + (size_t)tok * 1024;
  return (unsigned char*)p.Z() + (size_t)tok * (ZW * 2);
}

DEV void merge_tile(const Params& p, int layer, int tile, int MT, unsigned char* smem) {
  u16* sA = (u16*)smem;
  const int mt = tile % MT, nt = tile / MT;
  const int m0 = mt * 128, n0 = nt * 128;
  const int lane = tidx() & 63, w = tidx() >> 6, wm = w >> 1, wn = w & 1, q = lane & 15, g = lane >> 4;
  unsigned mp[4][4][2];
#pragma unroll
  for (int mi = 0; mi < 4; mi++)
#pragma unroll
    for (int ni = 0; ni < 4; ni++) mp[mi][ni][0] = mp[mi][ni][1] = 0u;
  const u16* Wb = p.WM() + WM_BR;
#pragma unroll 1
  for (int n = 0; n < 4; n++) {
    f32x4 pa[4][4];
    zero_acc<4>(pa);
    const u16* wbn = Wb + (size_t)n * 1024 * 512;
    if (n == 0) gemm_core<4, true>(pa, p.Q() + (size_t)m0 * 768, 768, wbn, 512, 512, n0, n0 + 32, 64, sA, sA);
    else if (n == 1) gemm_core<4, false>(pa, p.BRH() + (size_t)m0 * 512, 512, wbn, 512, 512, n0, n0 + 32, 64, sA, sA);
    else if (n == 2) gemm_core<4, false>(pa, p.Z() + (size_t)m0 * ZW + C_HY, ZW, wbn, 512, 512, n0, n0 + 32, 64, sA, sA);
    else gemm_core<4, false>(pa, p.Z() + (size_t)m0 * ZW + C_NQ, ZW, wbn, 512, 512, n0, n0 + 32, 64, sA, sA);
#pragma unroll
    for (int mi = 0; mi < 4; mi++) {
      const int tok = m0 + wm * 64 + mi * 16 + q;
      const unsigned char* gp = gate_ptr(p, n, tok) + n0 + wn * 64 + g * 4;
#pragma unroll
      for (int ni = 0; ni < 4; ni++) {
        const unsigned gv = *(const unsigned*)(gp + ni * 16);
        const float r0 = bflo(mp[mi][ni][0]) + (float)(gv & 255u) * (1.f / 255.f) * pa[mi][ni][0];
        const float r1 = bfhi(mp[mi][ni][0]) + (float)((gv >> 8) & 255u) * (1.f / 255.f) * pa[mi][ni][1];
        const float r2 = bflo(mp[mi][ni][1]) + (float)((gv >> 16) & 255u) * (1.f / 255.f) * pa[mi][ni][2];
        const float r3 = bfhi(mp[mi][ni][1]) + (float)(gv >> 24) * (1.f / 255.f) * pa[mi][ni][3];
        mp[mi][ni][0] = pack2(r0, r1);
        mp[mi][ni][1] = pack2(r2, r3);
      }
    }
  }
#pragma unroll
  for (int mi = 0; mi < 4; mi++) {
    const int tok = m0 + wm * 64 + mi * 16 + q;
#pragma unroll
    for (int ni = 0; ni < 4; ni++) {
      const int col = n0 + wn * 64 + ni * 16 + g * 4;
      uint2 o;
      o.x = mp[mi][ni][0];
      o.y = mp[mi][ni][1];
      *(uint2*)(p.M() + (size_t)tok * D + col) = o;
    }
  }
}

constexpr int G8_BK = 64, G8_HT = 128 * G8_BK;
DEV int g8_lds_byte(int r, int c) {
  int st = (r >> 4) * 2 + (c >> 5), rr = r & 15, cc = c & 31, ob = rr * 64 + cc * 2;
  return st * 1024 + (ob ^ (((ob >> 9) & 1) << 5));
}
DEV void g8_stage_rc(int b, int& R, int& C) {
  int st = b / 1024, sb = b % 1024, swz = sb ^ (((sb >> 9) & 1) << 5);
  R = (st >> 1) * 16 + swz / 64;
  C = (st & 1) * 32 + (swz % 64) / 2;
}
DEV void gemm8_core(f32x4 (&acc)[2][2][4][2], const u16* __restrict__ A, const u16* __restrict__ Bt, int K, int brow,
                    int bcol0, int bcol1, u16* shm) {
#define G8_SA(b, h) (shm + ((b) * 2 + (h)) * G8_HT)
#define G8_SB(b, h) (shm + (4 + (b) * 2 + (h)) * G8_HT)
#define G8_STAGE(P, RS, br, kt)                                                                            \
  do {                                                                                                     \
    const int _so = (int)((((long)(br) * K + (long)(kt) * G8_BK)) * 2);                                    \
    __builtin_amdgcn_raw_ptr_buffer_load_lds(RS, (__attribute__((address_space(3))) unsigned*)((char*)(P) + g8_b0), 16, \
                                             g8_so0, _so, 0, 0);                                           \
    __builtin_amdgcn_raw_ptr_buffer_load_lds(RS, (__attribute__((address_space(3))) unsigned*)((char*)(P) + g8_b0 + 8192), \
                                             16, g8_so1, _so, 0, 0);                                       \
  } while (0)
#define G8_LDA(dst, b, h)                                                                                  \
  for (int m = 0; m < 4; ++m)                                                                              \
    for (int k = 0; k < 2; ++k)                                                                            \
      dst[m][k] = *reinterpret_cast<const bf16x8*>((char*)G8_SA(b, h) + g8_lds_byte(wr * 64 + m * 16 + fr, k * 32 + fq * 8))
#define G8_LDB(dst, b, h)                                                                                  \
  for (int n = 0; n < 2; ++n)                                                                              \
    for (int k = 0; k < 2; ++k)                                                                            \
      dst[n][k] = *reinterpret_cast<const bf16x8*>((char*)G8_SB(b, h) + g8_lds_byte(wc * 32 + n * 16 + fr, k * 32 + fq * 8))
#define G8_MMA(ai, bj, At_, Bt_)                                                                           \
  do {                                                                                                     \
    __builtin_amdgcn_s_setprio(1);                                                                         \
    for (int m = 0; m < 4; ++m)                                                                            \
      for (int n = 0; n < 2; ++n)                                                                          \
        for (int k = 0; k < 2; ++k)                                                                        \
          acc[ai][bj][m][n] = __builtin_amdgcn_mfma_f32_16x16x32_bf16(Bt_[n][k], At_[m][k], acc[ai][bj][m][n], 0, 0, 0); \
    __builtin_amdgcn_s_setprio(0);                                                                         \
  } while (0)
#define G8_WAIT_V(n) asm volatile("s_waitcnt vmcnt(" #n ")" ::: "memory")
#define G8_WAIT_L(n) asm volatile("s_waitcnt lgkmcnt(" #n ")" ::: "memory")
#define G8_BAR __builtin_amdgcn_s_barrier()
#define G8_SCHED __builtin_amdgcn_sched_barrier(0)
  const int tx = tidx512();
  const int wid = tx >> 6, lane = tx & 63, wr = wid >> 2, wc = wid & 3, fr = lane & 15, fq = lane >> 4;
  const int g8_b0 = tx * 16;
  unsigned g8_so0, g8_so1;
  {
    int r_, c_;
    g8_stage_rc(g8_b0, r_, c_);
    g8_so0 = (unsigned)(r_ * K + c_) * 2u;
    g8_stage_rc(g8_b0 + 8192, r_, c_);
    g8_so1 = (unsigned)(r_ * K + c_) * 2u;
  }
  const __amdgpu_buffer_rsrc_t rsA = __builtin_amdgcn_make_buffer_rsrc((void*)A, (short)0, 0x7ffffff0, 0x00020000);
  const __amdgpu_buffer_rsrc_t rsB = __builtin_amdgcn_make_buffer_rsrc((void*)Bt, (short)0, 0x7ffffff0, 0x00020000);
  bf16x8 At[4][2], B0[2][2], B1[2][2];
  const int nt = K / G8_BK;
  G8_STAGE(G8_SB(0, 0), rsB, bcol0, 0); G8_STAGE(G8_SA(0, 0), rsA, brow, 0);
  G8_STAGE(G8_SB(0, 1), rsB, bcol1, 0); G8_STAGE(G8_SA(0, 1), rsA, brow + 128, 0);
  if (wr == 1) G8_BAR;
  G8_WAIT_V(4); G8_BAR;
  G8_STAGE(G8_SB(1, 0), rsB, bcol0, 1); G8_STAGE(G8_SA(1, 0), rsA, brow, 1); G8_STAGE(G8_SB(1, 1), rsB, bcol1, 1);
  G8_WAIT_V(6); G8_BAR;
#pragma unroll 1
  for (int t = 0; t < nt - 2; t += 2) {
    G8_LDB(B0, 0, 0); G8_SCHED; G8_LDA(At, 0, 0); G8_STAGE(G8_SA(1, 1), rsA, brow + 128, t + 1);
    G8_WAIT_L(8); G8_BAR; G8_WAIT_L(0); G8_MMA(0, 0, At, B0); G8_BAR; G8_SCHED;
    G8_LDB(B1, 0, 1); G8_STAGE(G8_SB(0, 0), rsB, bcol0, t + 2);
    G8_BAR; G8_WAIT_L(0); G8_MMA(0, 1, At, B1); G8_BAR;
    G8_LDA(At, 0, 1); G8_STAGE(G8_SA(0, 0), rsA, brow, t + 2);
    G8_BAR; G8_WAIT_L(0); G8_MMA(1, 0, At, B0); G8_BAR; G8_SCHED;
    G8_STAGE(G8_SB(0, 1), rsB, bcol1, t + 2);
    G8_WAIT_V(6); G8_BAR; G8_MMA(1, 1, At, B1); G8_BAR;
    G8_LDB(B0, 1, 0); G8_SCHED; G8_LDA(At, 1, 0); G8_STAGE(G8_SA(0, 1), rsA, brow + 128, t + 2);
    G8_WAIT_L(8); G8_BAR; G8_WAIT_L(0); G8_MMA(0, 0, At, B0); G8_BAR; G8_SCHED;
    G8_LDB(B1, 1, 1); G8_STAGE(G8_SB(1, 0), rsB, bcol0, t + 3);
    G8_BAR; G8_WAIT_L(0); G8_MMA(0, 1, At, B1); G8_BAR;
    G8_LDA(At, 1, 1); G8_STAGE(G8_SA(1, 0), rsA, brow, t + 3);
    G8_BAR; G8_WAIT_L(0); G8_MMA(1, 0, At, B0); G8_BAR; G8_SCHED;
    G8_STAGE(G8_SB(1, 1), rsB, bcol1, t + 3);
    G8_WAIT_V(6); G8_BAR; G8_MMA(1, 1, At, B1); G8_BAR;
  }
  {
    G8_LDB(B0, 0, 0); G8_LDA(At, 0, 0); G8_STAGE(G8_SA(1, 1), rsA, brow + 128, nt - 1);
    G8_BAR; G8_WAIT_L(0); G8_MMA(0, 0, At, B0); G8_BAR;
    G8_LDB(B1, 0, 1); G8_BAR; G8_WAIT_L(0); G8_MMA(0, 1, At, B1); G8_BAR;
    G8_LDA(At, 0, 1); G8_WAIT_V(4); G8_BAR; G8_WAIT_L(0); G8_MMA(1, 0, At, B0); G8_MMA(1, 1, At, B1); G8_BAR;
  }
  {
    G8_LDB(B0, 1, 0); G8_LDA(At, 1, 0); G8_WAIT_V(2); G8_BAR; G8_WAIT_L(0); G8_MMA(0, 0, At, B0); G8_BAR;
    G8_LDB(B1, 1, 1); G8_WAIT_V(0); G8_BAR; G8_WAIT_L(0); G8_MMA(0, 1, At, B1); G8_BAR;
    G8_LDA(At, 1, 1); G8_BAR; G8_WAIT_L(0); G8_MMA(1, 0, At, B0); G8_MMA(1, 1, At, B1); G8_BAR;
  }
  if (wr == 0) G8_BAR;
#undef G8_SA
#undef G8_SB
#undef G8_STAGE
#undef G8_LDA
#undef G8_LDB
#undef G8_MMA
#undef G8_WAIT_V
#undef G8_WAIT_L
#undef G8_BAR
#undef G8_SCHED
}

DEV void g8_zero(f32x4 (&acc)[2][2][4][2]) {
#pragma unroll
  for (int a = 0; a < 2; a++)
#pragma unroll
    for (int b = 0; b < 2; b++)
#pragma unroll
      for (int m = 0; m < 4; m++)
#pragma unroll
        for (int n = 0; n < 2; n++) acc[a][b][m][n] = f32x4{0.f, 0.f, 0.f, 0.f};
}

DEV void ffn_in_tile8(const Params& p, int which, int tile, int MT, unsigned char* smem_all) {
  const int mt = tile % MT, nt = tile / MT;
  const int brow = mt * 256, j0 = nt * 128;
  f32x4 acc[2][2][4][2];
  g8_zero(acc);
  asm volatile("s_waitcnt vmcnt(0)" ::: "memory");
  __syncthreads();
  const u16* W = p.WF() + (size_t)which * WF_ELEMS + WF_IN;
  gemm8_core(acc, p.H(), W, 1024, brow, j0, FH + j0, (u16*)smem_all);
  const int tx = tidx512();
  const int wid = tx >> 6, lane = tx & 63, wr = wid >> 2, wc = wid & 3, fr = lane & 15, fq = lane >> 4;
#pragma unroll
  for (int ai = 0; ai < 2; ai++)
#pragma unroll
    for (int m = 0; m < 4; m++) {
      const int tok = brow + ai * 128 + wr * 64 + m * 16 + fr;
#pragma unroll
      for (int n = 0; n < 2; n++) {
        const f32x4 a = acc[ai][0][m][n], b = acc[ai][1][m][n];
        const int col = j0 + wc * 32 + n * 16 + fq * 4;
        uint2 o;
        o.x = pack2(siluf_(a[0]) * b[0], siluf_(a[1]) * b[1]);
        o.y = pack2(siluf_(a[2]) * b[2], siluf_(a[3]) * b[3]);
        *(uint2*)(p.HID() + (size_t)tok * FH + col) = o;
      }
    }
}

DEV void inproj_tile8(const Params& p, int tile, int MT, unsigned char* smem_all) {
  const int mt = tile % MT, nt = tile / MT;
  const int brow = mt * 256, n0 = nt * 256;
  f32x4 acc[2][2][4][2];
  g8_zero(acc);
  asm volatile("s_waitcnt vmcnt(0)" ::: "memory");
  __syncthreads();
  gemm8_core(acc, p.H(), p.WM() + WM_WIN, 1024, brow, n0, n0 + 128, (u16*)smem_all);
  const int tx = tidx512();
  const int wid = tx >> 6, lane = tx & 63, wr = wid >> 2, wc = wid & 3, fr = lane & 15, fq = lane >> 4;
#pragma unroll
  for (int ai = 0; ai < 2; ai++)
#pragma unroll
    for (int m = 0; m < 4; m++) {
      const int tok = brow + ai * 128 + wr * 64 + m * 16 + fr;
      int b, key;
      row_bk(tok, b, key);
#pragma unroll
      for (int bj = 0; bj < 2; bj++)
#pragma unroll
        for (int n = 0; n < 2; n++) {
          const int col = n0 + bj * 128 + wc * 32 + n * 16 + fq * 4;
          if (col < ZW) {
            const f32x4 a = acc[ai][bj][m][n];
            uint2 o;
            o.x = pack2(a[0], a[1]);
            o.y = pack2(a[2], a[3]);
            *(uint2*)(p.Z() + (size_t)tok * ZW + col) = o;
            if (col >= C_NV && col < C_U) {
              const int hh = (col - C_NV) >> 6, e = (col - C_NV) & 63;
              u16* dst = p.NVT() + ((size_t)(b * 8 + hh) * 64 + e) * KEYS + key;
              dst[0] = (u16)(o.x & 0xffff);
              dst[KEYS] = (u16)(o.x >> 16);
              dst[2 * KEYS] = (u16)(o.y & 0xffff);
              dst[3 * KEYS] = (u16)(o.y >> 16);
            }
          }
        }
    }
}

template <int K>
DEV void f32out_tile8(const Params& p, const u16* A, const u16* W, int tile, int MT, unsigned char* smem_all) {
  const int mt = tile % MT, nt = tile / MT;
  const int brow = mt * 256, n0 = nt * 256;
  f32x4 acc[2][2][4][2];
  g8_zero(acc);
  asm volatile("s_waitcnt vmcnt(0)" ::: "memory");
  __syncthreads();
  gemm8_core(acc, A, W, K, brow, n0, n0 + 128, (u16*)smem_all);
  const int tx = tidx512();
  const int wid = tx >> 6, lane = tx & 63, wr = wid >> 2, wc = wid & 3, fr = lane & 15, fq = lane >> 4;
#pragma unroll
  for (int ai = 0; ai < 2; ai++)
#pragma unroll
    for (int m = 0; m < 4; m++) {
      const int tok = brow + ai * 128 + wr * 64 + m * 16 + fr;
      u16* yrow = (u16*)p.Y() + (size_t)tok * D + n0 + wc * 32 + fq * 4;
#pragma unroll
      for (int bj = 0; bj < 2; bj++)
#pragma unroll
        for (int n = 0; n < 2; n++) {
          const f32x4 a = acc[ai][bj][m][n];
          uint2 o;
          o.x = pack2(a[0], a[1]);
          o.y = pack2(a[2], a[3]);
          *(uint2*)(yrow + bj * 128 + n * 16) = o;
        }
    }
}

DEV void gate_tile8(const Params& p, int tile, int MT, unsigned char* smem_all) {
  const int mt = tile % MT, nt = tile / MT;
  const int brow = mt * 256, n0 = nt * 256;
  f32x4 acc[2][2][4][2];
  g8_zero(acc);
  asm volatile("s_waitcnt vmcnt(0)" ::: "memory");
  __syncthreads();
  gemm8_core(acc, p.H(), p.WM() + WM_WIN, 1024, brow, C_GATE + n0, C_GATE + n0 + 128, (u16*)smem_all);
  const int tx = tidx512();
  const int wid = tx >> 6, lane = tx & 63, wr = wid >> 2, wc = wid & 3, fr = lane & 15, fq = lane >> 4;
  const int br_n = n0 >> 10, d0 = n0 & 1023;
#pragma unroll
  for (int ai = 0; ai < 2; ai++)
#pragma unroll
    for (int m = 0; m < 4; m++) {
      const int tok = brow + ai * 128 + wr * 64 + m * 16 + fr;
      unsigned char* gp = gate_ptr(p, br_n, tok) + d0 + wc * 32 + fq * 4;
#pragma unroll
      for (int bj = 0; bj < 2; bj++)
#pragma unroll
        for (int n = 0; n < 2; n++) {
          const f32x4 a = acc[ai][bj][m][n];
          const unsigned u0 = (unsigned)(sigmoidf_(a[0]) * 255.f + 0.5f), u1 = (unsigned)(sigmoidf_(a[1]) * 255.f + 0.5f);
          const unsigned u2 = (unsigned)(sigmoidf_(a[2]) * 255.f + 0.5f), u3 = (unsigned)(sigmoidf_(a[3]) * 255.f + 0.5f);
          *(unsigned*)(gp + bj * 128 + n * 16) = u0 | (u1 << 8) | (u2 << 16) | (u3 << 24);
        }
    }
}

DEV void mla_norm_row(const Params& p, int layer, int r, bool dry = false) {
  const int lane = tidx() & 63;
  u16* zr = p.Z() + (size_t)r * ZW;
  {
    uint2 v = *(const uint2*)(zr + C_CKV + lane * 4);
    float a0 = bflo(v.x), a1 = bfhi(v.x), a2 = bflo(v.y), a3 = bfhi(v.y);
    float ss = wave_sum(a0 * a0 + a1 * a1 + a2 * a2 + a3 * a3);
    float rstd = rsqrtf(ss * (1.f / 256.f) + EPS);
    float4 g4 = *(const float4*)(p.mla_g_kv + layer * 256 + lane * 4);
    uint2 o;
    o.x = pack2(a0 * rstd * g4.x, a1 * rstd * g4.y);
    o.y = pack2(a2 * rstd * g4.z, a3 * rstd * g4.w);
    if (!dry) *(uint2*)(zr + C_CKV + lane * 4) = o;
  }
  {
    uint2 v = *(const uint2*)(zr + C_CQ + lane * 4);
    float a0 = bflo(v.x), a1 = bfhi(v.x), a2 = bflo(v.y), a3 = bfhi(v.y);
    float ss = wave_sum(a0 * a0 + a1 * a1 + a2 * a2 + a3 * a3);
    float rstd = rsqrtf(ss * (1.f / 256.f) + EPS);
    float4 g4 = *(const float4*)(p.mla_g_q + layer * 256 + lane * 4);
    uint2 o;
    o.x = pack2(a0 * rstd * g4.x, a1 * rstd * g4.y);
    o.y = pack2(a2 * rstd * g4.z, a3 * rstd * g4.w);
    if (!dry) *(uint2*)(zr + C_CQ + lane * 4) = o;
  }
  {
    float xm = bf2f(zr[C_KR + lane]);
    float xo = __shfl_xor(xm, 16);
    float val = xm;
    if (r < NL) {
      const float2 rr = p.ROPE()[(size_t)(r & 2047) * 32 + ((lane >> 5) << 4) + (lane & 15)];
      const float cs = rr.x, sn = rr.y;
      val = (lane & 16) ? (xm * cs + xo * sn) : (xm * cs - xo * sn);
    }
    int b, key;
    row_bk(r, b, key);
    const u16 hv = f2bf(val);
#pragma unroll
    for (int hh = 0; hh < 4; hh++) p.Kb()[((size_t)(b * 4 + hh) * KEYS + key) * 192 + 128 + lane] = hv;
  }
}

template <int DQK, int DV, class BiasF>
DEV void attn_group(const bf16x8 (&qf)[DQK / 32], f32x4 (&o)[DV / 16], float& m, float& l, const u16* k0p,
                    const u16* k1p, const u16* vt, int vts, float scale, BiasF bias) {
  const int lane = tidx() & 63, q = lane & 15, g = lane >> 4;
  f32x4 s0 = {0.f, 0.f, 0.f, 0.f}, s1 = {0.f, 0.f, 0.f, 0.f};
#pragma unroll
  for (int ds = 0; ds < DQK / 32; ds++) {
    bf16x8 kf0 = *(const bf16x8*)(k0p + ds * 32 + g * 8);
    bf16x8 kf1 = *(const bf16x8*)(k1p + ds * 32 + g * 8);
    s0 = __builtin_amdgcn_mfma_f32_16x16x32_bf16(kf0, qf[ds], s0, 0, 0, 0);
    s1 = __builtin_amdgcn_mfma_f32_16x16x32_bf16(kf1, qf[ds], s1, 0, 0, 0);
  }
  float sv[8];
#pragma unroll
  for (int j = 0; j < 4; j++) {
    sv[j] = s0[j] * scale + bias(g * 4 + j);
    sv[4 + j] = s1[j] * scale + bias(16 + g * 4 + j);
  }
  float mx = sv[0];
#pragma unroll
  for (int j = 1; j < 8; j++) mx = fmaxf(mx, sv[j]);
  mx = fmaxf(mx, __shfl_xor(mx, 16));
  mx = fmaxf(mx, __shfl_xor(mx, 32));
  const float mn = fmaxf(m, mx);
  const float alpha = __expf(m - mn);
  m = mn;
  float ps = 0.f;
  float pv[8];
#pragma unroll
  for (int j = 0; j < 8; j++) {
    pv[j] = __expf(sv[j] - mn);
    ps += pv[j];
  }
  l = l * alpha + ps;
  union { bf16x8 v; unsigned u[4]; } pf;
  pf.u[0] = pack2(pv[0], pv[1]);
  pf.u[1] = pack2(pv[2], pv[3]);
  pf.u[2] = pack2(pv[4], pv[5]);
  pf.u[3] = pack2(pv[6], pv[7]);
#pragma unroll
  for (int et = 0; et < DV / 16; et++) {
    const u16* vp = vt + (size_t)(et * 16 + q) * vts + g * 4;
    union { bf16x8 v; uint2 u[2]; } vf;
    vf.u[0] = *(const uint2*)(vp);
    vf.u[1] = *(const uint2*)(vp + 16);
    f32x4 oo = o[et];
    oo[0] *= alpha; oo[1] *= alpha; oo[2] *= alpha; oo[3] *= alpha;
    o[et] = __builtin_amdgcn_mfma_f32_16x16x32_bf16(vf.v, pf.v, oo, 0, 0, 0);
  }
}

template <int DV>
DEV void attn_store(const f32x4 (&o)[DV / 16], float l, u16* orow, bool dry = false) {
  const int lane = tidx() & 63, g = lane >> 4;
  l += __shfl_xor(l, 16);
  l += __shfl_xor(l, 32);
  const float inv = 1.f / l;
#pragma unroll
  for (int et = 0; et < DV / 16; et++) {
    uint2 ov;
    ov.x = pack2(o[et][0] * inv, o[et][1] * inv);
    ov.y = pack2(o[et][2] * inv, o[et][3] * inv);
    if (!dry) *(uint2*)(orow + et * 16 + g * 4) = ov;
  }
}

DEV void mla_attn_wave(const Params& p, int wt, bool dry = false) {
  const int lane = tidx() & 63, q = lane & 15, g = lane >> 4;
  int b, hh, row0, ngroups;
  if (wt < 4096) {
    const int qt = wt & 127;
    hh = (wt >> 7) & 3;
    b = wt >> 9;
    row0 = b * 2048 + qt * 16;
    ngroups = 72;
  } else {
    const int w2 = wt - 4096;
    const int qt = w2 & 15;
    hh = (w2 >> 4) & 3;
    b = w2 >> 6;
    row0 = NL + b * 256 + qt * 16;
    ngroups = 8;
  }
  u16* qrow = p.Q() + (size_t)(row0 + q) * 768 + hh * 192;
  bf16x8 qf[6];
#pragma unroll
  for (int ds = 0; ds < 6; ds++) qf[ds] = *(const bf16x8*)(qrow + ds * 32 + g * 8);
  f32x4 o[8];
#pragma unroll
  for (int et = 0; et < 8; et++) o[et] = f32x4{0.f, 0.f, 0.f, 0.f};
  float m = -INFINITY, l = 0.f;
  const u16* Kbase = p.Kb() + (size_t)(b * 4 + hh) * KEYS * 192;
  const u16* Vbase = p.VT() + (size_t)(b * 4 + hh) * 128 * KEYS;
  const float scale = 0.07216878364870322f;
  auto nobias = [](int) { return 0.f; };
  for (int kg = 0; kg < ngroups; kg++) {
    const int kb = kg * 32;
    attn_group<192, 128>(qf, o, m, l, Kbase + (size_t)(kb + q) * 192, Kbase + (size_t)(kb + 16 + q) * 192,
                         Vbase + kb, KEYS, scale, nobias);
  }
  attn_store<128>(o, l, qrow, dry);
}

DEV void softmax_step(const f32x4& s0, const f32x4& s1, float scale, float& m, float& l, bf16x8& pfo, float& alpha) {
  const float sc2 = scale * 1.4426950408889634f;
  float sv[8];
#pragma unroll
  for (int j = 0; j < 4; j++) {
    sv[j] = s0[j] * sc2;
    sv[4 + j] = s1[j] * sc2;
  }
  float mx = sv[0];
#pragma unroll
  for (int j = 1; j < 8; j++) mx = fmaxf(mx, sv[j]);
  mx = fmaxf(mx, __shfl_xor(mx, 16));
  mx = fmaxf(mx, __shfl_xor(mx, 32));
  const float mn = fmaxf(m, mx);
  alpha = __builtin_amdgcn_exp2f(m - mn);
  m = mn;
  float ps = 0.f, pv[8];
#pragma unroll
  for (int j = 0; j < 8; j++) {
    pv[j] = __builtin_amdgcn_exp2f(sv[j] - mn);
    ps += pv[j];
  }
  l = l * alpha + ps;
  union { bf16x8 v; unsigned u[4]; } pf;
  pf.u[0] = pack2(pv[0], pv[1]);
  pf.u[1] = pack2(pv[2], pv[3]);
  pf.u[2] = pack2(pv[4], pv[5]);
  pf.u[3] = pack2(pv[6], pv[7]);
  pfo = pf.v;
}

DEV void na_attn_block(const Params& p, int layer, int task, unsigned char* smem, bool dry) {
  constexpr int KS = 72, VS = 40;
  constexpr int STG = 32 * KS + 64 * VS;
  u16* sm = (u16*)smem;
  const int tid = tidx(), lane = tid & 63, w = tid >> 6, q = lane & 15, g = lane >> 4;
  const bool lat = task < 2048;
  int b, hh, gr = 0, row0;
  if (lat) {
    hh = task & 7; gr = (task >> 3) & 31; b = task >> 8;
    row0 = b * 2048 + gr * 64 + w * 16;
  } else {
    const int t2 = task - 2048;
    const int qb = t2 & 3;
    hh = (t2 >> 2) & 7; b = t2 >> 5;
    row0 = NL + b * 256 + qb * 64 + w * 16;
  }
  const int ng = lat ? 24 : 8;
  u16* qrow = p.Z() + (size_t)(row0 + q) * ZW + C_NQ + hh * 64;
  bf16x8 qf[2];
  qf[0] = *(const bf16x8*)(qrow + g * 8);
  qf[1] = *(const bf16x8*)(qrow + 32 + g * 8);
  f32x4 o[4];
#pragma unroll
  for (int et = 0; et < 4; et++) o[et] = f32x4{0.f, 0.f, 0.f, 0.f};
  float m = -INFINITY, l = 0.f;
  const u16* Vbase = p.NVT() + (size_t)(b * 8 + hh) * 64 * KEYS;
  const int rbase = min(max(gr - 4, 0), 24);
  const int qc = w * 16 + q;
  const int c0 = min(max(qc - 8, 0), 48);
  const int klo = min(max(w * 16 - 8, 0), 48), khi = min(max(w * 16 + 15 - 8, 0), 48) + 15;
  const float* rpb = p.na_rpb + ((size_t)layer * 8 + hh) * 15 * 31;
  const int krow_l = tid >> 3, kch = tid & 7, ve = tid >> 2, vch = tid & 3;
  u32x4 r0k, r0v, r1k, r1v;
#define NA_GLOAD(R, kg_)                                                                                    \
  {                                                                                                      \
    const int kg__ = (kg_);                                                                              \
    const int l2__ = kg__ - 8;                                                                           \
    const int tokb__ = (rbase + (l2__ >> 1)) * 64 + (l2__ & 1) * 32;                                     \
    const int rowb__ = kg__ < 8 ? NL + b * 256 + kg__ * 32 : b * 2048 + tokb__;                          \
    const int keyb__ = kg__ < 8 ? kg__ * 32 : 256 + tokb__;                                              \
    R##k = *(const u32x4*)(p.Z() + (size_t)(rowb__ + krow_l) * ZW + C_NK + hh * 64 + kch * 8);               \
    R##v = *(const u32x4*)(Vbase + (size_t)ve * KEYS + keyb__ + vch * 8);                                  \
  }
#define NA_LSTORE(R, st_)                                                                                   \
  {                                                                                                      \
    u16* st__ = (st_);                                                                                   \
    *(u32x4*)(st__ + krow_l * KS + kch * 8) = R##k;                                                        \
    *(u32x4*)(st__ + 32 * KS + ve * VS + vch * 8) = R##v;                                                  \
  }
  auto compute = [&](const int kg, const u16* sk) __attribute__((always_inline)) {
    const u16* sv = sk + 32 * KS;
    bool active = true;
    int kc0 = 0;
    const float* rp = rpb;
    if (kg >= 8) {
      const int l2 = kg - 8;
      kc0 = (l2 & 1) * 32;
      active = !(kc0 > khi || kc0 + 31 < klo);
      rp = rpb + (rbase + (l2 >> 1) - gr + 7) * 31;
    }
    if (active) {
      f32x4 s0 = {0.f, 0.f, 0.f, 0.f}, s1 = {0.f, 0.f, 0.f, 0.f};
#pragma unroll
      for (int ds = 0; ds < 2; ds++) {
        const bf16x8 kf0 = *(const bf16x8*)(sk + q * KS + ds * 32 + g * 8);
        const bf16x8 kf1 = *(const bf16x8*)(sk + (16 + q) * KS + ds * 32 + g * 8);
        s0 = __builtin_amdgcn_mfma_f32_16x16x32_bf16(kf0, qf[ds], s0, 0, 0, 0);
        s1 = __builtin_amdgcn_mfma_f32_16x16x32_bf16(kf1, qf[ds], s1, 0, 0, 0);
      }
      bf16x8 pf;
      float alpha;
      f32x4 bz0 = {0.f, 0.f, 0.f, 0.f}, bz1 = {0.f, 0.f, 0.f, 0.f};
      if (kg >= 8) {
#pragma unroll
        for (int j = 0; j < 4; j++) {
          const int ka = kc0 + g * 4 + j, kb2 = ka + 16;
          const float va = rp[min(max(ka - qc + 15, 0), 30)];
          const float vb = rp[min(max(kb2 - qc + 15, 0), 30)];
          bz0[j] = ((ka >= c0) && (ka < c0 + 16)) ? va : -INFINITY;
          bz1[j] = ((kb2 >= c0) && (kb2 < c0 + 16)) ? vb : -INFINITY;
        }
      }
      s0 = s0 * 0.125f + bz0;
      s1 = s1 * 0.125f + bz1;
      softmax_step(s0, s1, 1.0f, m, l, pf, alpha);
#pragma unroll
      for (int et = 0; et < 4; et++) {
        union { bf16x8 v; uint2 u[2]; } vf;
        vf.u[0] = *(const uint2*)(sv + (et * 16 + q) * VS + g * 4);
        vf.u[1] = *(const uint2*)(sv + (et * 16 + q) * VS + 16 + g * 4);
        f32x4 oo = o[et];
        oo[0] *= alpha; oo[1] *= alpha; oo[2] *= alpha; oo[3] *= alpha;
        o[et] = __builtin_amdgcn_mfma_f32_16x16x32_bf16(vf.v, pf, oo, 0, 0, 0);
      }
    }
  };
  __syncthreads();
  NA_GLOAD(r0, 0);
  NA_GLOAD(r1, 1);
  NA_LSTORE(r0, sm);
  __syncthreads();
#pragma unroll 1
  for (int kg = 0; kg < ng; kg += 2) {
    NA_GLOAD(r0, min(kg + 2, ng - 1));
    compute(kg, sm);
    NA_LSTORE(r1, sm + STG);
    __syncthreads();
    NA_GLOAD(r1, min(kg + 3, ng - 1));
    compute(kg + 1, sm + STG);
    NA_LSTORE(r0, sm);
    __syncthreads();
  }
  attn_store<64>(o, l, qrow, dry);
#undef NA_GLOAD
#undef NA_LSTORE
}

DEV void mla_attn_block(const Params& p, int task, unsigned char* smem, bool dry) {
  constexpr int KS = 200, VS = 40;
  constexpr int STG = 32 * KS + 128 * VS;
  u16* sm = (u16*)smem;
  const int tid = tidx(), lane = tid & 63, w = tid >> 6, q = lane & 15, g = lane >> 4;
  int b, hh, row0, ng;
  if (task < 512) {
    const int qb = task & 15;
    hh = (task >> 4) & 3;
    b = task >> 6;
    row0 = b * 2048 + qb * 128;
    ng = 72;
  } else {
    const int t2 = task - 512;
    const int qb = t2 & 1;
    hh = (t2 >> 1) & 3;
    b = t2 >> 3;
    row0 = NL + b * 256 + qb * 128;
    ng = 8;
  }
  u16* qrow0 = p.Q() + (size_t)(row0 + w * 32 + q) * 768 + hh * 192;
  u16* qrow1 = qrow0 + (size_t)16 * 768;
  bf16x8 qf[2][6];
#pragma unroll
  for (int ds = 0; ds < 6; ds++) {
    qf[0][ds] = *(const bf16x8*)(qrow0 + ds * 32 + g * 8);
    qf[1][ds] = *(const bf16x8*)(qrow1 + ds * 32 + g * 8);
  }
  f32x4 o[2][8];
#pragma unroll
  for (int qt = 0; qt < 2; qt++)
#pragma unroll
    for (int et = 0; et < 8; et++) o[qt][et] = f32x4{0.f, 0.f, 0.f, 0.f};
  float m[2] = {-INFINITY, -INFINITY}, l[2] = {0.f, 0.f};
  const u16* Kbase = p.Kb() + (size_t)(b * 4 + hh) * KEYS * 192;
  const u16* Vbase = p.VT() + (size_t)(b * 4 + hh) * 128 * KEYS;
  const float scale = 0.07216878364870322f;
  int krow[3], kch[3];
#pragma unroll
  for (int i = 0; i < 3; i++) {
    const int c = tid + i * 256;
    krow[i] = c / 24;
    kch[i] = c % 24;
  }
  const int ve0 = tid >> 2, vch = tid & 3;
  u32x4 r0k0, r0k1, r0k2, r0v0, r0v1, r1k0, r1k1, r1k2, r1v0, r1v1;
#define MLA_GL(R, kg_)                                                                           \
  {                                                                                              \
    const int kb__ = (kg_) * 32;                                                                 \
    R##k0 = *(const u32x4*)(Kbase + (size_t)(kb__ + krow[0]) * 192 + kch[0] * 8);                \
    R##k1 = *(const u32x4*)(Kbase + (size_t)(kb__ + krow[1]) * 192 + kch[1] * 8);                \
    R##k2 = *(const u32x4*)(Kbase + (size_t)(kb__ + krow[2]) * 192 + kch[2] * 8);                \
    R##v0 = *(const u32x4*)(Vbase + (size_t)ve0 * KEYS + kb__ + vch * 8);                        \
    R##v1 = *(const u32x4*)(Vbase + (size_t)(ve0 + 64) * KEYS + kb__ + vch * 8);                 \
  }
#define MLA_LS(R, st_)                                                                           \
  {                                                                                              \
    u16* st__ = (st_);                                                                           \
    *(u32x4*)(st__ + krow[0] * KS + kch[0] * 8) = R##k0;                                         \
    *(u32x4*)(st__ + krow[1] * KS + kch[1] * 8) = R##k1;                                         \
    *(u32x4*)(st__ + krow[2] * KS + kch[2] * 8) = R##k2;                                         \
    *(u32x4*)(st__ + 32 * KS + ve0 * VS + vch * 8) = R##v0;                                      \
    *(u32x4*)(st__ + 32 * KS + (ve0 + 64) * VS + vch * 8) = R##v1;                               \
  }
  auto compute = [&](const u16* sk) __attribute__((always_inline)) {
    const u16* sv = sk + 32 * KS;
    f32x4 s[2][2];
#pragma unroll
    for (int qt = 0; qt < 2; qt++) s[qt][0] = s[qt][1] = f32x4{0.f, 0.f, 0.f, 0.f};
#pragma unroll
    for (int ds = 0; ds < 6; ds++) {
      const bf16x8 kf0 = *(const bf16x8*)(sk + q * KS + ds * 32 + g * 8);
      const bf16x8 kf1 = *(const bf16x8*)(sk + (16 + q) * KS + ds * 32 + g * 8);
#pragma unroll
      for (int qt = 0; qt < 2; qt++) {
        s[qt][0] = __builtin_amdgcn_mfma_f32_16x16x32_bf16(kf0, qf[qt][ds], s[qt][0], 0, 0, 0);
        s[qt][1] = __builtin_amdgcn_mfma_f32_16x16x32_bf16(kf1, qf[qt][ds], s[qt][1], 0, 0, 0);
      }
    }
    bf16x8 pf[2];
    float alpha0, alpha1;
    softmax_step(s[0][0], s[0][1], scale, m[0], l[0], pf[0], alpha0);
    softmax_step(s[1][0], s[1][1], scale, m[1], l[1], pf[1], alpha1);
    if (__any((alpha0 != 1.f) || (alpha1 != 1.f))) {
#pragma unroll
      for (int et = 0; et < 8; et++) {
        o[0][et][0] *= alpha0; o[0][et][1] *= alpha0; o[0][et][2] *= alpha0; o[0][et][3] *= alpha0;
        o[1][et][0] *= alpha1; o[1][et][1] *= alpha1; o[1][et][2] *= alpha1; o[1][et][3] *= alpha1;
      }
    }
#pragma unroll
    for (int et = 0; et < 8; et++) {
      union { bf16x8 v; uint2 u[2]; } vf;
      vf.u[0] = *(const uint2*)(sv + (et * 16 + q) * VS + g * 4);
      vf.u[1] = *(const uint2*)(sv + (et * 16 + q) * VS + 16 + g * 4);
#pragma unroll
      for (int qt = 0; qt < 2; qt++) o[qt][et] = __builtin_amdgcn_mfma_f32_16x16x32_bf16(vf.v, pf[qt], o[qt][et], 0, 0, 0);
    }
  };
  __syncthreads();
  MLA_GL(r0, 0);
  MLA_GL(r1, 1);
  MLA_LS(r0, sm);
  __syncthreads();
#pragma unroll 1
  for (int kg = 0; kg < ng; kg += 2) {
    MLA_GL(r0, min(kg + 2, ng - 1));
    compute(sm);
    MLA_LS(r1, sm + STG);
    __syncthreads();
    MLA_GL(r1, min(kg + 3, ng - 1));
    compute(sm + STG);
    MLA_LS(r0, sm);
    __syncthreads();
  }
#undef MLA_GL
#undef MLA_LS
  attn_store<128>(o[0], l[0], qrow0, dry);
  attn_store<128>(o[1], l[1], qrow1, dry);
}

DEV void na_attn_wave(const Params& p, int layer, int wt, bool dry = false) {
  const int lane = tidx() & 63, q = lane & 15, g = lane >> 4;
  const float scale = 0.125f;
  auto nobias = [](int) { return 0.f; };
  f32x4 o[4];
#pragma unroll
  for (int et = 0; et < 4; et++) o[et] = f32x4{0.f, 0.f, 0.f, 0.f};
  float m = -INFINITY, l = 0.f;
  bf16x8 qf[2];
  if (wt < 8192) {
    const int qt = wt & 3, hh = (wt >> 2) & 7, gr = (wt >> 5) & 31, b = wt >> 10;
    const int row0 = b * 2048 + gr * 64 + qt * 16;
    u16* qrow = p.Z() + (size_t)(row0 + q) * ZW + C_NQ + hh * 64;
    qf[0] = *(const bf16x8*)(qrow + g * 8);
    qf[1] = *(const bf16x8*)(qrow + 32 + g * 8);
    const u16* Vbase = p.NVT() + (size_t)(b * 8 + hh) * 64 * KEYS;
    for (int kg = 0; kg < 8; kg++) {
      const int kb = kg * 32;
      const u16* k0p = p.Z() + (size_t)(NL + b * 256 + kb + q) * ZW + C_NK + hh * 64;
      attn_group<64, 64>(qf, o, m, l, k0p, k0p + (size_t)16 * ZW, Vbase + kb, KEYS, scale, nobias);
    }
    const int rbase = min(max(gr - 4, 0), 24);
    const int qc = qt * 16 + q;
    const int c0 = min(max(qc - 8, 0), 48);
    const int klo = min(max(qt * 16 - 8, 0), 48), khi = min(max(qt * 16 + 15 - 8, 0), 48) + 15;
    const float* rpb = p.na_rpb + ((size_t)layer * 8 + hh) * 15 * 31;
    for (int kr = 0; kr < 8; kr++) {
      const int krow = rbase + kr;
      const float* rp = rpb + (krow - gr + 7) * 31;
      for (int half = 0; half < 2; half++) {
        const int kc0 = half * 32;
        if (kc0 > khi || kc0 + 31 < klo) continue;
        const int tokb = krow * 64 + kc0;
        const u16* k0p = p.Z() + (size_t)(b * 2048 + tokb + q) * ZW + C_NK + hh * 64;
        auto bias = [&](int kl) {
          const int kc = kc0 + kl;
          const bool inw = (kc >= c0) && (kc < c0 + 16);
          const int dc = min(max(kc - qc + 15, 0), 30);
          return inw ? rp[dc] : -INFINITY;
        };
        attn_group<64, 64>(qf, o, m, l, k0p, k0p + (size_t)16 * ZW, Vbase + 256 + tokb, KEYS, scale, bias);
      }
    }
    attn_store<64>(o, l, qrow, dry);
  } else {
    const int w2 = wt - 8192;
    const int qt = w2 & 15, hh = (w2 >> 4) & 7, b = w2 >> 7;
    const int row0 = NL + b * 256 + qt * 16;
    u16* qrow = p.Z() + (size_t)(row0 + q) * ZW + C_NQ + hh * 64;
    qf[0] = *(const bf16x8*)(qrow + g * 8);
    qf[1] = *(const bf16x8*)(qrow + 32 + g * 8);
    const u16* Vbase = p.NVT() + (size_t)(b * 8 + hh) * 64 * KEYS;
    for (int kg = 0; kg < 8; kg++) {
      const int kb = kg * 32;
      const u16* k0p = p.Z() + (size_t)(NL + b * 256 + kb + q) * ZW + C_NK + hh * 64;
      attn_group<64, 64>(qf, o, m, l, k0p, k0p + (size_t)16 * ZW, Vbase + kb, KEYS, scale, nobias);
    }
    attn_store<64>(o, l, qrow, dry);
  }
}

DEV void hypre_tile(const Params& p, int layer, int tile, unsigned char* smem) {
  u16* sS = (u16*)smem;
  const int tid = tidx();
  int b, tt, ct, L, rowbase, soff;
  if (tile < 2048) {
    ct = tile & 7; tt = (tile >> 3) & 31; b = tile >> 8;
    L = SEQ; rowbase = b * 2048; soff = 256;
  } else {
    const int t2 = tile - 2048;
    ct = t2 & 7; tt = (t2 >> 3) & 3; b = t2 >> 5;
    L = CTXL; rowbase = NL + b * 256; soff = 0;
  }
  const int cg = tid & 7, tl0 = tid >> 3;
  const int c8 = ct * 64 + cg * 8;
  const float* cw = p.hy_conv_w + layer * 3 * 1536;
  const float* cbp = p.hy_conv_b + layer * 1536;
  float vv[2][8];
  __syncthreads();
#pragma unroll 1
  for (int sgrp = 0; sgrp < 3; sgrp++) {
    float wt[3][8], bs[8];
    {
      const float4 b0 = *(const float4*)(cbp + sgrp * 512 + c8), b1 = *(const float4*)(cbp + sgrp * 512 + c8 + 4);
      bs[0] = b0.x; bs[1] = b0.y; bs[2] = b0.z; bs[3] = b0.w; bs[4] = b1.x; bs[5] = b1.y; bs[6] = b1.z; bs[7] = b1.w;
#pragma unroll
      for (int j = 0; j < 3; j++) {
        const float4 w0 = *(const float4*)(cw + j * 1536 + sgrp * 512 + c8), w1 = *(const float4*)(cw + j * 1536 + sgrp * 512 + c8 + 4);
        wt[j][0] = w0.x; wt[j][1] = w0.y; wt[j][2] = w0.z; wt[j][3] = w0.w;
        wt[j][4] = w1.x; wt[j][5] = w1.y; wt[j][6] = w1.z; wt[j][7] = w1.w;
      }
    }
#pragma unroll
    for (int tk = 0; tk < 2; tk++) {
      const int tl = tl0 + tk * 32;
      const int t = tt * 64 + tl;
      float a[8];
#pragma unroll
      for (int e = 0; e < 8; e++) a[e] = bs[e];
#pragma unroll
      for (int j = 0; j < 3; j++) {
        const int ts = t + j - 1;
        if (ts >= 0 && ts < L) {
          const uint4 z = *(const uint4*)(p.Z() + (size_t)(rowbase + ts) * ZW + C_HY + sgrp * 512 + c8);
          a[0] += bflo(z.x) * wt[j][0]; a[1] += bfhi(z.x) * wt[j][1];
          a[2] += bflo(z.y) * wt[j][2]; a[3] += bfhi(z.y) * wt[j][3];
          a[4] += bflo(z.z) * wt[j][4]; a[5] += bfhi(z.z) * wt[j][5];
          a[6] += bflo(z.w) * wt[j][6]; a[7] += bfhi(z.w) * wt[j][7];
        }
      }
      if (sgrp == 0) {
#pragma unroll
        for (int e = 0; e < 8; e++) vv[tk][e] = a[e];
      } else if (sgrp == 1) {
#pragma unroll
        for (int e = 0; e < 8; e++) sS[(cg * 8 + e) * 72 + tl] = f2bf(vv[tk][e] * a[e]);
      } else {
        uint4 o;
        o.x = pack2(a[0], a[1]); o.y = pack2(a[2], a[3]); o.z = pack2(a[4], a[5]); o.w = pack2(a[6], a[7]);
        *(uint4*)(p.BRH() + (size_t)(rowbase + t) * 512 + c8) = o;
      }
    }
  }
  __syncthreads();
  for (int i = tid; i < 64 * 8; i += 256) {
    const int cc = i >> 3, t8 = i & 7;
    uint4 v = *(const uint4*)(sS + cc * 72 + t8 * 8);
    *(uint4*)(p.ST() + ((size_t)(b * 512) + ct * 64 + cc) * KEYS + soff + tt * 64 + t8 * 8) = v;
  }
}

DEV void hyena_task(const Params& p, int layer, int task, unsigned char* smem, bool dry = false) {
  constexpr int CPS = 4112;
  u16* sK = (u16*)smem;
  constexpr int SRS = 2080;
  u16* sS = sK + 4 * CPS;
  const int tid = tidx(), lane = tid & 63, w = tid >> 6, q = lane & 15, g = lane >> 4;
  const bool isctx = task >= 512;
  const int c = isctx ? task - 512 : task;
  const int L = isctx ? CTXL : SEQ;
  const int RW = isctx ? RKC : RKL;
  const int soff = isctx ? 0 : 256;
  const int rowb = isctx ? NL : 0;
  const u16* rk = p.RK() + (size_t)layer * RK_LAYER + (isctx ? (size_t)512 * RKL : 0) + (size_t)c * RW;
  __syncthreads();
  for (int i = tid; i < CPS / 8; i += 256) {
    uint4 v = make_uint4(0, 0, 0, 0);
    if (i * 8 < RW) v = *(const uint4*)(rk + i * 8);
    *(uint4*)(sK + i * 8) = v;
  }
  for (int i = tid; i < 8 * (L / 8); i += 256) {
    const int bb = i / (L / 8), i8 = i % (L / 8);
    *(uint4*)(sS + bb * SRS + i8 * 8) = *(const uint4*)(p.ST() + ((size_t)bb * 512 + c) * KEYS + soff + i8 * 8);
  }
  __syncthreads();
  const int n4 = RW / 4;
  for (int i = tid; i < 3 * n4; i += 256) {
    const int mcp = 1 + i / n4, i4 = i % n4;
    union { uint2 v; u16 s[4]; } t;
#pragma unroll
    for (int e = 0; e < 4; e++) t.s[e] = sK[i4 * 4 + mcp + e];
    *(uint2*)(sK + mcp * CPS + i4 * 4) = t.v;
  }
  __syncthreads();
  const int Dm = L - 1;
  const int ngrp = L / 128;
  const u16* sp = sS + (q & 7) * SRS + g * 8;
#define HY_LD(dst, o_)                                                     \
  {                                                                        \
    const int o__ = (o_);                                                  \
    const int mcp__ = o__ & 3, base__ = o__ & ~3;                          \
    union { bf16x8 v; uint2 u[2]; } f__;                                   \
    f__.u[0] = *(const uint2*)(sK + mcp__ * CPS + base__);                 \
    f__.u[1] = *(const uint2*)(sK + mcp__ * CPS + base__ + 4);             \
    dst = f__.v;                                                           \
  }
  for (int grp = w; grp < ngrp; grp += 4) {
    f32x4 acc[8];
#pragma unroll
    for (int ti = 0; ti < 8; ti++) acc[ti] = f32x4{0.f, 0.f, 0.f, 0.f};
    const int tb = grp * 128;
    const int obase = Dm - tb - q + g * 8;
    bf16x8 A[8];
#pragma unroll
    for (int ti = 2; ti < 8; ti++) HY_LD(A[ti], obase - 16 * ti);
#pragma unroll 1
    for (int s0 = 0; s0 < L; s0 += 128) {
#pragma unroll
      for (int u = 0; u < 4; u++) {
        const int sc = s0 + 32 * u;
        bf16x8 bfrag = *(const bf16x8*)(sp + sc);
        if (q >= 8) bfrag = bf16x8{0, 0, 0, 0, 0, 0, 0, 0};
        HY_LD(A[(8 - 2 * u) & 7], obase + sc);
        HY_LD(A[(9 - 2 * u) & 7], obase - 16 + sc);
#pragma unroll
        for (int ti = 0; ti < 8; ti++)
          acc[ti] = __builtin_amdgcn_mfma_f32_16x16x32_bf16(A[(ti + 8 - 2 * u) & 7], bfrag, acc[ti], 0, 0, 0);
      }
    }
    if (q < 8) {
#pragma unroll
      for (int ti = 0; ti < 8; ti++)
#pragma unroll
        for (int j = 0; j < 4; j++) {
          const int t = tb + ti * 16 + g * 4 + j;
          u16* dst = p.BRH() + (size_t)(rowb + q * L + t) * 512 + c;
          const u16 nv = f2bf(bf2f(*dst) * acc[ti][j]);
          if (!dry) *dst = nv;
        }
    }
  }
#undef HY_LD
}

DEV void s5_decode(int wt, int& b, int& g, int& chunk, int& row0) {
  chunk = wt % NCH;
  const int bg = wt / NCH;
  g = bg & 31;
  b = bg >> 5;
  row0 = chunk < 8 ? NL + b * 256 + chunk * 32 : b * 2048 + (chunk - 8) * 32;
}

using f32x16 = __attribute__((ext_vector_type(16))) float;
template <int dir>
DEV void s5_p1_dir(const Params& p, int layer, int b, int g, int chunk, int c, int hh, const bf16x8& ua) {
  const int ldg = (layer * 2 + dir) * 32 + g;
  const float* sp = p.S5P() + (size_t)ldg * 2304;
  float Lr[2][4], Li[2][4], qr[2], qi[2];
#pragma unroll
  for (int st = 0; st < 2; st++) {
    const float lr = sp[st * 32 + c], li = sp[64 + st * 32 + c];
    const float tr = lr * lr - li * li, ti = 2.f * lr * li;
    qr[st] = tr * tr - ti * ti;
    qi[st] = 2.f * tr * ti;
    f32x16 zr, zi;
#pragma unroll
    for (int i = 0; i < 16; i++) { zr[i] = 0.f; zi[i] = 0.f; }
    const bf16x8 bre = *(const bf16x8*)(p.S5PB() + ((size_t)ldg * 128 + st * 32 + c) * 16 + hh * 8);
    const bf16x8 bim = *(const bf16x8*)(p.S5PB() + ((size_t)ldg * 128 + 64 + st * 32 + c) * 16 + hh * 8);
    const f32x16 bur = __builtin_amdgcn_mfma_f32_32x32x16_bf16(ua, bre, zr, 0, 0, 0);
    const f32x16 bui = __builtin_amdgcn_mfma_f32_32x32x16_bf16(ua, bim, zi, 0, 0, 0);
#pragma unroll
    for (int sl = 0; sl < 4; sl++) {
      float xr = 0.f, xi = 0.f;
#pragma unroll
      for (int jj = 0; jj < 4; jj++) {
        const int r = sl * 4 + (dir == 0 ? jj : 3 - jj);
        const float nr = lr * xr - li * xi + bur[r];
        const float ni = lr * xi + li * xr + bui[r];
        xr = nr; xi = ni;
      }
      Lr[st][sl] = xr; Li[st][sl] = xi;
    }
  }
  float cr[2] = {0.f, 0.f}, ci[2] = {0.f, 0.f};
#pragma unroll
  for (int ss = 0; ss < 8; ss++) {
    const int sgm = dir == 0 ? ss : 7 - ss;
    const int sl = sgm >> 1;
    const int src = c + 32 * (sgm & 1);
#pragma unroll
    for (int st = 0; st < 2; st++) {
      const float ar = __shfl(Lr[st][sl], src);
      const float ai = __shfl(Li[st][sl], src);
      const float nr = qr[st] * cr[st] - qi[st] * ci[st] + ar;
      const float ni = qr[st] * ci[st] + qi[st] * cr[st] + ai;
      cr[st] = nr; ci[st] = ni;
    }
  }
  if (hh == 0) {
    float2* F = (float2*)p.S5F() + ((size_t)((b * 32 + g) * 2 + dir) * NCH + chunk) * 64;
    F[c] = make_float2(cr[0], ci[0]);
    F[32 + c] = make_float2(cr[1], ci[1]);
  }
}

DEV void s5_pass1_wave(const Params& p, int layer, int wt, unsigned char* smem) {
  const int lane = tidx() & 63, c = lane & 31, hh = lane >> 5;
  int b, g, chunk, row0;
  s5_decode(wt, b, g, chunk, row0);
  const bf16x8 ua = *(const bf16x8*)(p.Z() + (size_t)(row0 + c) * ZW + C_U + g * 16 + hh * 8);
  s5_p1_dir<0>(p, layer, b, g, chunk, c, hh, ua);
  __builtin_amdgcn_sched_barrier(0);
  s5_p1_dir<1>(p, layer, b, g, chunk, c, hh, ua);
  __builtin_amdgcn_sched_barrier(0);
}

DEV void s5_prefix_phase(const Params& p, const int layer) {
  const int tx = tidx512();
  const int lane = tx & 63;
  const int nwv = gridDim.x * 8;
  for (int wt = blockIdx.x * 8 + (tx >> 6); wt < NB * 32 * 2; wt += nwv) {
    const int dir = wt & 1, g = (wt >> 1) & 31, b = wt >> 6;
    const float* sp = p.S5P() + (size_t)((layer * 2 + dir) * 32 + g) * 2304;
    const float cr = sp[128 + lane], ci = sp[192 + lane];
    float2* F = (float2*)p.S5F() + ((size_t)((b * 32 + g) * 2 + dir) * NCH) * 64 + lane;
    float xr = 0.f, xi = 0.f;
#pragma unroll 1
    for (int j0 = 0; j0 < NCH; j0 += 8) {
      float2 fb[8];
      int cjs[8];
#pragma unroll
      for (int jj = 0; jj < 8; jj++) {
        const int j = j0 + jj;
        cjs[jj] = dir == 0 ? j : (j < 8 ? 7 - j : 79 - j);
        fb[jj] = F[(size_t)cjs[jj] * 64];
      }
#pragma unroll
      for (int jj = 0; jj < 8; jj++) {
        F[(size_t)cjs[jj] * 64] = make_float2(xr, xi);
        const float nr = cr * xr - ci * xi + fb[jj].x;
        const float ni = cr * xi + ci * xr + fb[jj].y;
        xr = nr; xi = ni;
      }
    }
  }
}

template <int dir>
DEV void s5_p2_dir(const Params& p, int layer, int b, int g, int chunk, int lane, const bf16x8& ua, u16* XS) {
  const int c = lane & 31, hh = lane >> 5;
  const int ldg = (layer * 2 + dir) * 32 + g;
  const float* sp = p.S5P() + (size_t)ldg * 2304;
  const float2* Fin = (const float2*)p.S5F() + ((size_t)((b * 32 + g) * 2 + dir) * NCH + chunk) * 64;
#pragma unroll
  for (int st = 0; st < 2; st++) {
    const int pst = st * 32 + c;
    const float2 fin = Fin[pst];
    float cr_ = fin.x, ci_ = fin.y;
    const float lr = sp[pst], li = sp[64 + pst];
    const float p2r = lr * lr - li * li, p2i = 2.f * lr * li;
    const float p3r = p2r * lr - p2i * li, p3i = p2r * li + p2i * lr;
    const float p4r = p2r * p2r - p2i * p2i, p4i = 2.f * p2r * p2i;
    f32x16 zr, zi;
#pragma unroll
    for (int i = 0; i < 16; i++) { zr[i] = 0.f; zi[i] = 0.f; }
    const bf16x8 bre = *(const bf16x8*)(p.S5PB() + ((size_t)ldg * 128 + pst) * 16 + hh * 8);
    const bf16x8 bim = *(const bf16x8*)(p.S5PB() + ((size_t)ldg * 128 + 64 + pst) * 16 + hh * 8);
    f32x16 vr = __builtin_amdgcn_mfma_f32_32x32x16_bf16(ua, bre, zr, 0, 0, 0);
    f32x16 vi = __builtin_amdgcn_mfma_f32_32x32x16_bf16(ua, bim, zi, 0, 0, 0);
    float Lr[4], Li[4];
#pragma unroll
    for (int sl = 0; sl < 4; sl++) {
      float ar = 0.f, ai = 0.f;
#pragma unroll
      for (int jj = 0; jj < 4; jj++) {
        const int r = sl * 4 + (dir == 0 ? jj : 3 - jj);
        const float nr = lr * ar - li * ai + vr[r];
        const float ni = lr * ai + li * ar + vi[r];
        ar = nr; ai = ni;
        vr[r] = ar; vi[r] = ai;
      }
      Lr[sl] = ar; Li[sl] = ai;
    }
    float Cr[4], Ci[4];
#pragma unroll
    for (int sl = 0; sl < 4; sl++) { Cr[sl] = 0.f; Ci[sl] = 0.f; }
#pragma unroll
    for (int ss = 0; ss < 8; ss++) {
      const int sgm = dir == 0 ? ss : 7 - ss;
      const int sl = sgm >> 1;
      const bool mine = hh == (sgm & 1);
      const int src = c + 32 * (sgm & 1);
      const float ar = __shfl(Lr[sl], src);
      const float ai = __shfl(Li[sl], src);
      Cr[sl] = mine ? cr_ : Cr[sl];
      Ci[sl] = mine ? ci_ : Ci[sl];
      const float nr = p4r * cr_ - p4i * ci_ + ar;
      const float ni = p4r * ci_ + p4i * cr_ + ai;
      cr_ = nr; ci_ = ni;
    }
#pragma unroll
    for (int sl = 0; sl < 4; sl++) {
#pragma unroll
      for (int jj = 0; jj < 4; jj++) {
        const int r = sl * 4 + jj;
        const int stp = dir == 0 ? jj : 3 - jj;
        const float wr = stp == 0 ? lr : (stp == 1 ? p2r : (stp == 2 ? p3r : p4r));
        const float wi = stp == 0 ? li : (stp == 1 ? p2i : (stp == 2 ? p3i : p4i));
        const float xr_ = vr[r] + wr * Cr[sl] - wi * Ci[sl];
        const float xi_ = vi[r] + wr * Ci[sl] + wi * Cr[sl];
        const int t = jj + 8 * sl + 4 * hh;
        XS[t * 264 + dir * 128 + pst] = f2bf(xr_);
        XS[t * 264 + dir * 128 + 64 + pst] = f2bf(xi_);
      }
    }
  }
}

DEV void s5_pass2_block(const Params& p, int layer, int blk, unsigned char* smem, bool dry = false) {
  const int tid = tidx(), lane = tid & 63, w = tid >> 6, q = lane & 15, gq = lane >> 4;
  u16* XS = (u16*)smem + w * (32 * 264);
  int b, g, chunk, row0;
  s5_decode(blk * 4 + w, b, g, chunk, row0);
  __syncthreads();
  {
    const bf16x8 ua = *(const bf16x8*)(p.Z() + (size_t)(row0 + (lane & 31)) * ZW + C_U + g * 16 + (lane >> 5) * 8);
    s5_p2_dir<0>(p, layer, b, g, chunk, lane, ua, XS);
    __builtin_amdgcn_sched_barrier(0);
    s5_p2_dir<1>(p, layer, b, g, chunk, lane, ua, XS);
    __builtin_amdgcn_sched_barrier(0);
  }
  __syncthreads();
  f32x4 y0 = {0.f, 0.f, 0.f, 0.f}, y1 = {0.f, 0.f, 0.f, 0.f};
#pragma unroll
  for (int ks = 0; ks < 8; ks++) {
    union { bf16x8 v; unsigned u[4]; } cf;
    cf.v = *(const bf16x8*)(p.S5PC() + ((size_t)(layer * 32 + g) * 16 + q) * 256 + ks * 32 + gq * 8);
    bf16x8 x0 = *(const bf16x8*)(XS + q * 264 + ks * 32 + gq * 8);
    bf16x8 x1 = *(const bf16x8*)(XS + (16 + q) * 264 + ks * 32 + gq * 8);
    y0 = __builtin_amdgcn_mfma_f32_16x16x32_bf16(cf.v, x0, y0, 0, 0, 0);
    y1 = __builtin_amdgcn_mfma_f32_16x16x32_bf16(cf.v, x1, y1, 0, 0, 0);
  }
  const float4 d4 = *(const float4*)(p.s5_d + layer * 512 + g * 16 + gq * 4);
  const float dd[4] = {d4.x, d4.y, d4.z, d4.w};
#pragma unroll
  for (int mt = 0; mt < 2; mt++) {
    u16* zp = p.Z() + (size_t)(row0 + mt * 16 + q) * ZW + C_U + g * 16 + gq * 4;
    uint2 uv = *(const uint2*)zp;
    const float uf[4] = {bflo(uv.x), bfhi(uv.x), bflo(uv.y), bfhi(uv.y)};
    float r[4];
#pragma unroll
    for (int j = 0; j < 4; j++) {
      float y = (mt == 0 ? y0[j] : y1[j]) + dd[j] * uf[j];
      float inner = 0.7978845608028654f * (y + 0.044715f * y * y * y);
      r[j] = 0.5f * y * (1.f + tanhf(inner));
    }
    uint2 o;
    o.x = pack2(r[0], r[1]);
    o.y = pack2(r[2], r[3]);
    __syncthreads();
    if (!dry) *(uint2*)zp = o;
  }
}

DEV int xcd_slot64(int v) { return ((v >> 4) << 1) | (v & 1); }
DEV int mla_task_remap(int v) { return (((v >> 1) & 7) << 6) | xcd_slot64(v); }
DEV int na_task_remap(int u) {
  const int v = u & 511, i = u >> 9;
  const int c = (((v >> 1) & 7) << 8) | (i << 6) | xcd_slot64(v);
  const int bh = c >> 5, gr = c & 31;
  return ((bh >> 3) << 8) | (gr << 3) | (bh & 7);
}

#ifndef PH_MASK
#define PH_MASK 0xFFFF
#endif
#define PHON(k) ((PH_MASK >> (k)) & 1)
#ifndef SUB_MASK
#define SUB_MASK 0xFF
#endif
#define SUBON(k) ((SUB_MASK >> (k)) & 1)
#ifndef REPEAT_SUB
#define REPEAT_SUB 0xFF
#endif
#define DRYON(k) (!dry || ((REPEAT_SUB >> (k)) & 1))
DEV void run_phase(const Params& p, const int ph, unsigned char* smem_all, const bool dry = false) {
  const int hb = __builtin_amdgcn_readfirstlane((int)(threadIdx.x >> 8));
  unsigned char* smem = smem_all + hb * SMEM_BYTES;
  const int bid = blockIdx.x * 2 + hb, nb = gridDim.x * 2;
  if (ph == 0) {
    if (!PHON(13)) return;
    {
      const float4* sx = (const float4*)p.x;
      float4* dx = (float4*)p.out;
      for (size_t i = (size_t)bid * 256 + tidx(); i < (size_t)NL * D / 4; i += (size_t)nb * 256) dx[i] = sx[i];
      const float4* sc = (const float4*)p.ctx;
      float4* dc = (float4*)p.xc();
      for (size_t i = (size_t)bid * 256 + tidx(); i < (size_t)NC * D / 4; i += (size_t)nb * 256) dc[i] = sc[i];
    }
    for (int t = bid; t < 288 + WF_TILES; t += nb) {
      if (t < 288) mods_task(p, t, smem);
      else wconv_ffn(p, 0, 0, t - 288, smem);
    }
    return;
  }
  if (ph == 1) {
    if (!PHON(14)) return;
    for (int r = bid * 4 + (tidx() >> 6); r < NT; r += nb * 4) norm1_row(p, r);
    return;
  }
  const int layer = (ph - 2) / 13, k = (ph - 2) % 13;
  const bool last = layer == 1;
  const int MT_ALL = NT / 128, MT_LAT = NL / 128;
  switch (k) {
    case 0: if (PHON(0)) {
      const int MT = MT_ALL / 2, ntile = MT * 22;
      for (int t = blockIdx.x; t < ntile; t += gridDim.x) ffn_in_tile8(p, 0, t, MT, smem_all);
      __syncthreads();
    } break;
    case 1: if (PHON(1)) {
      const int MT = MT_ALL / 2, ntile = MT * 4;
      const u16* W = p.WF() + WF_OUT;
      for (int t = blockIdx.x; t < ntile; t += gridDim.x) f32out_tile8<FH>(p, p.HID(), W, t, MT, smem_all);
      __syncthreads();
      if (layer == 0) {
        const int nlate = max(0, ntile - (int)gridDim.x);
        if ((int)blockIdx.x >= nlate) {
          const int vb = ((int)blockIdx.x - nlate) * 2 + hb, nvb = ((int)gridDim.x - nlate) * 2;
          for (int t = vb; t < 576 + 32 + WM_TILES + 256; t += nvb) {
            if (t < 576) hyfilt_task(p, t, smem);
            else if (t < 608) s5pre_task(p, t - 576);
            else if (t < 608 + WM_TILES) wconv_mixer(p, 0, t - 608, smem);
            else rope_task(p, t - 608 - WM_TILES);
          }
        }
      }
    } break;
    case 2: if (PHON(2)) {
      for (int r = bid * 4 + (tidx() >> 6); r < NT; r += nb * 4) resid_row(p, r, layer, 0.5f, 2, 1, true, layer, 2, 3, 4, dry);
    } break;
    case 3: if (PHON(3)) {
      const int MT = MT_ALL / 2, ntile = MT * 17;
      for (int t = blockIdx.x; t < ntile; t += gridDim.x) inproj_tile8(p, t, MT, smem_all);
      __syncthreads();
    } break;
    case 4: if (PHON(4)) {
      const int n_hp = last ? 2048 : 2304;
      const int n_s5 = (NB * 32 * NCH) / 4;
      const int n_mn = NT / 4;
      const int total = n_hp + n_s5 + n_mn;
      for (int t = bid; t < total; t += nb) {
        if (t < n_hp) { if (DRYON(0)) hypre_tile(p, layer, t, smem); }
        else if (t < n_hp + n_s5) { if (DRYON(1)) s5_pass1_wave(p, layer, (t - n_hp) * 4 + (tidx() >> 6), smem); }
        else if (DRYON(2)) mla_norm_row(p, layer, (t - n_hp - n_s5) * 4 + (tidx() >> 6), dry);
      }
    } break;
    case 5: if (PHON(5)) {
      const int n_hy = last ? 512 : 1024;
      const int n_na = last ? 2048 : 2304;
      const int n_s5 = (NB * 32 * NCH) / 4;
      const int n_kv = MT_ALL * 8;
      const int MTq = last ? MT_LAT : MT_ALL;
      const int n_q = MTq * 6;
      const int total = n_hy + n_na + n_s5 + n_kv + n_q;
      for (int t = bid; t < total; t += nb) {
        int u = t;
        if (u < n_hy) { if (SUBON(0) && DRYON(0)) hyena_task(p, layer, u, smem, dry); continue; }
        u -= n_hy;
        if (u < n_na) { if (SUBON(1) && DRYON(1)) na_attn_block(p, layer, u < 2048 ? na_task_remap(u) : u, smem, dry); continue; }
        u -= n_na;
        if (u < n_s5) {
          const int chunk0 = (u * 4) % NCH;
          if (last && chunk0 < 8) continue;
          if (SUBON(2) && DRYON(2)) s5_pass2_block(p, layer, u, smem, dry);
          continue;
        }
        u -= n_s5;
        if (u < n_kv) { if (SUBON(3) && DRYON(3)) kvup_tile(p, layer, u, MT_ALL, smem); continue; }
        u -= n_kv;
        if (SUBON(4) && DRYON(4)) qup_tile(p, layer, u, MTq, smem);
      }
    } break;
    case 6: if (PHON(6)) {
      const int n_at = last ? 512 : 576;
      const int MT = last ? MT_LAT : MT_ALL;
      const int n_gl = MT * 8;
      const int total = n_at + n_gl;
      {
        const int MTg = MT / 2, ngate = MTg * 16;
        for (int t = blockIdx.x; t < ngate; t += gridDim.x) gate_tile8(p, t, MTg, smem_all);
        __syncthreads();
      }
      for (int t = bid; t < total; t += nb) {
        if (t < n_at) mla_attn_block(p, t < 512 ? mla_task_remap(t) : t, smem, dry);
        else glu_tile(p, layer, t - n_at, MT, smem);
      }
    } break;
    case 7: if (PHON(7)) {
      const int MT = last ? MT_LAT : MT_ALL, ntile = MT * 8;
      for (int t = bid; t < ntile; t += nb) merge_tile(p, layer, t, MT, smem);
    } break;
    case 8: if (PHON(8)) {
      const int MT = (last ? MT_LAT : MT_ALL) / 2, ntile = MT * 4;
      const u16* W = p.WM() + WM_OUT;
      for (int t = blockIdx.x; t < ntile; t += gridDim.x) f32out_tile8<D>(p, p.M(), W, t, MT, smem_all);
      __syncthreads();
      {
        const int nlate = max(0, ntile - (int)gridDim.x);
        if ((int)blockIdx.x >= nlate) {
          const int vb = ((int)blockIdx.x - nlate) * 2 + hb, nvb = ((int)gridDim.x - nlate) * 2;
          for (int t = vb; t < WF_TILES; t += nvb) wconv_ffn(p, layer, 1, t, smem);
        }
      }
    } break;
    case 9: if (PHON(9)) {
      const int nr = last ? NL : NT;
      for (int r = bid * 4 + (tidx() >> 6); r < nr; r += nb * 4) resid_row(p, r, layer, 1.0f, 5, 3, true, layer, 4, 6, 7, dry);
    } break;
    case 10: if (PHON(10)) {
      const int MT = (last ? MT_LAT : MT_ALL) / 2, ntile = MT * 22;
      for (int t = blockIdx.x; t < ntile; t += gridDim.x) ffn_in_tile8(p, 1, t, MT, smem_all);
      __syncthreads();
    } break;
    case 11: if (PHON(11)) {
      const int MT = (last ? MT_LAT : MT_ALL) / 2, ntile = MT * 4;
      const u16* W = p.WF() + WF_ELEMS + WF_OUT;
      for (int t = blockIdx.x; t < ntile; t += gridDim.x) f32out_tile8<FH>(p, p.HID(), W, t, MT, smem_all);
      __syncthreads();
      if (!last) {
        const int nlate = max(0, ntile - (int)gridDim.x);
        if ((int)blockIdx.x >= nlate) {
          const int vb = ((int)blockIdx.x - nlate) * 2 + hb, nvb = ((int)gridDim.x - nlate) * 2;
          for (int t = vb; t < WM_TILES + WF_TILES; t += nvb) {
            if (t < WM_TILES) wconv_mixer(p, 1, t, smem);
            else wconv_ffn(p, 1, 0, t - WM_TILES, smem);
          }
        }
      }
    } break;
    case 12: if (PHON(12)) {
      const int nr = last ? NL : NT;
      for (int r = bid * 4 + (tidx() >> 6); r < nr; r += nb * 4) resid_row(p, r, layer, 0.5f, 8, 5, !last, layer + 1, 0, 0, 1, dry);
    } break;
  }
}


#define XB_TMO      128
#define XB_XCNT(j)  (256  + 64 * (j))
#define XB_XSUB(j)  (1280 + 64 * (j))
#define XB_XGEN(j)  (2304 + 64 * (j))
#define XB_TOP      3328
#define XB_TOPGEN   3392
#define XCD_BAR_WORDS 3456
#define XB_SPIN_CAP (1u << 20)
#define LAS __attribute__((address_space(3)))
__device__ __forceinline__ unsigned xb_ld(unsigned* p)              { return __hip_atomic_load(p, __ATOMIC_RELAXED, __HIP_MEMORY_SCOPE_AGENT); }
__device__ __forceinline__ unsigned xb_add(unsigned* p, unsigned v) { return __hip_atomic_fetch_add(p, v, __ATOMIC_RELAXED, __HIP_MEMORY_SCOPE_AGENT); }
__device__ __forceinline__ unsigned xb_xcc_id() { return (unsigned)__builtin_amdgcn_s_getreg((3 << 11) | 20) & 0xFu; }
#define XB_SPIN(cond, bar) do { unsigned _sp = 0; while (cond) { __builtin_amdgcn_s_sleep(1); \
    if ((++_sp & 255u) == 0u) { if (xb_ld(&(bar)[XB_TMO])) break; if (_sp > XB_SPIN_CAP) { atomicAdd(&(bar)[XB_TMO], 1u); break; } } } } while (0)
struct XcdBarrier { unsigned* bar; unsigned x; volatile LAS unsigned* st; };
__device__ __forceinline__ XcdBarrier xcd_barrier_post(unsigned* bar, volatile LAS unsigned* st) {
    XcdBarrier b; b.bar = bar; b.x = xb_xcc_id(); b.st = st;
    if (threadIdx.x == 0) (void)xb_add(&bar[XB_XCNT(b.x)], 1u);
    return b;
}
__device__ __forceinline__ void xcd_barrier_complete(unsigned* bar, unsigned x, unsigned& nloc, unsigned& nx) {
    const unsigned G = gridDim.x * gridDim.y * gridDim.z;
    unsigned sum, cnt, mine, sp = 0u;
    for (;;) {
        sum = 0u; cnt = 0u; mine = 0u;
#pragma unroll
        for (unsigned j = 0; j < 16; ++j) { const unsigned c = xb_ld(&bar[XB_XCNT(j)]); sum += c; cnt += (c > 0u) ? 1u : 0u; mine = (j == x) ? c : mine; }
        if (sum == G) break;
        __builtin_amdgcn_s_sleep(1);
        if ((++sp & 255u) == 0u) { if (xb_ld(&bar[XB_TMO])) break; if (sp > XB_SPIN_CAP) { atomicAdd(&bar[XB_TMO], 1u); break; } }
    }
    nloc = mine > 0u ? mine : 1u; nx = cnt > 0u ? cnt : 1u;
}
__device__ __forceinline__ void xcd_barrier(const XcdBarrier& b) {
    asm volatile("s_waitcnt vmcnt(0)" ::: "memory");
    __syncthreads();
    if (threadIdx.x == 0) {
        unsigned* bar = b.bar;
        __builtin_amdgcn_s_waitcnt(0);
        unsigned nloc = b.st[0], nx = b.st[1];
        if (nloc == 0u) { xcd_barrier_complete(bar, b.x, nloc, nx); b.st[0] = nloc; b.st[1] = nx; }
        const unsigned old = xb_add(&bar[XB_XSUB(b.x)], 1u);
        const unsigned gen = old / nloc;
        if (old + 1u == (gen + 1u) * nloc) {
            __builtin_amdgcn_fence(__ATOMIC_RELEASE, "agent");
            asm volatile("s_waitcnt vmcnt(0)" ::: "memory");
            const unsigned og = xb_add(&bar[XB_TOP], 1u);
            const unsigned tg = og / nx;
            if (og + 1u == (tg + 1u) * nx) xb_add(&bar[XB_TOPGEN], 1u);
            else XB_SPIN(xb_ld(&bar[XB_TOPGEN]) == tg, bar);
            __builtin_amdgcn_fence(__ATOMIC_ACQUIRE, "agent");
            xb_add(&bar[XB_XGEN(b.x)], 1u);
            asm volatile("s_waitcnt vmcnt(0)" ::: "memory");
        } else {
            XB_SPIN(xb_ld(&bar[XB_XGEN(b.x)]) == gen, bar);
            __builtin_amdgcn_fence(__ATOMIC_ACQUIRE, "agent");
            asm volatile("s_waitcnt vmcnt(0)" ::: "memory");
        }
    }
    __syncthreads();
}

constexpr int N_PHASES = 2 + 26;

__global__ void __launch_bounds__(512, 2) mega_kernel(Params p, int ph_lo, int ph_hi) {
  __shared__ __attribute__((aligned(16))) unsigned char smem[SMEM_TOTAL];
  uint4* xbw = (uint4*)(smem + 2 * SMEM_BYTES);
  if (threadIdx.x == 0) *xbw = make_uint4(0u, 0u, 0u, 0u);
  __syncthreads();
  XcdBarrier xb = xcd_barrier_post(p.bar(), (volatile LAS unsigned*)xbw);
  if (ph_lo < 0) cg::this_grid().sync();
#define RP(i) run_phase(p, (i), smem); xcd_barrier(xb);
  RP(0) RP(1) RP(2) RP(3) RP(4) RP(5) RP(6)
  s5_prefix_phase(p, 0); xcd_barrier(xb);
  RP(7) RP(8) RP(9) RP(10) RP(11) RP(12) RP(13) RP(14)
  RP(15) RP(16) RP(17) RP(18) RP(19)
  s5_prefix_phase(p, 1); xcd_barrier(xb);
  RP(20) RP(21) RP(22) RP(23) RP(24) RP(25) RP(26)
  run_phase(p, 27, smem);
#undef RP
}

static inline size_t align_up(size_t v) { return (v + 255) & ~(size_t)255; }

extern "C" void kernel_launch(void* const* d_in, const int* in_sizes, int n_in, void* d_out, int out_size, void* d_ws,
                              size_t ws_size, hipStream_t stream) {
  Params p{};
  const float** pp = (const float**)&p;
  for (int i = 0; i < 37; i++) pp[i] = (const float*)d_in[i];
  p.out = (float*)d_out;
  p.ws = (unsigned char*)d_ws;
  if (WS_TOTAL > ws_size) { fprintf(stderr, "workspace too small: need %zu have %zu\n", (size_t)WS_TOTAL, ws_size); return; }

  static int grid_blocks = 0;
  if (!grid_blocks) {
    int dev = 0, cus = 0, per_cu = 0;
    hipGetDevice(&dev);
    hipDeviceGetAttribute(&cus, hipDeviceAttributeMultiprocessorCount, dev);
    hipOccupancyMaxActiveBlocksPerMultiprocessor(&per_cu, mega_kernel, 512, 0);
    if (per_cu > 1) per_cu = 1;
    grid_blocks = cus * per_cu;
  }
  hipMemsetAsync(p.ws + OFF_BAR, 0, (size_t)XCD_BAR_WORDS * 4, stream);
  int lo = 0, hi = N_PHASES;
  void* args[] = {&p, &lo, &hi};
  hipError_t e = hipLaunchCooperativeKernel((void*)mega_kernel, dim3(grid_blocks), dim3(512), args, 0, stream);
  if (e != hipSuccess) fprintf(stderr, "cooperative launch failed: %s (grid %d)\n", hipGetErrorString(e), grid_blocks);
}
```

```cpp
#define ONE_LAUNCH 1
#include <hip/hip_runtime.h>
#include <hip/hip_bf16.h>
#include <hip/hip_cooperative_groups.h>
#include <cstdio>
namespace cg = cooperative_groups;

typedef unsigned short u16;
using bf16x8 = __attribute__((ext_vector_type(8))) short;
using f32x4 = __attribute__((ext_vector_type(4))) float;
using f32x2 = __attribute__((ext_vector_type(2))) float;
using u32x4 = __attribute__((ext_vector_type(4))) unsigned int;

#define DEV __device__ __forceinline__

constexpr int D = 1024, NB = 8, SEQ = 2048, CTXL = 256;
constexpr int NL = NB * SEQ, NC = NB * CTXL, NT = NL + NC;
constexpr int FH = 2816, NIN = 8256, ZW = 4224;
constexpr int C_CKV = 0, C_KR = 256, C_NK = 320, C_NV = 832, C_U = 1344, C_CQ = 1856, C_NQ = 2112, C_HY = 2624, C_GATE = 4160;
constexpr int KEYS = 2304;
constexpr int NCH = 72;
constexpr int RKL = 4096, RKC = 512;
constexpr int RK_LAYER = 512 * RKL + 512 * RKC;
constexpr int SMEM_BYTES = 77824;
constexpr int SMEM_TOTAL = 2 * SMEM_BYTES + 16;
constexpr float EPS = 1e-6f;

constexpr size_t ws_au(size_t v) { return (v + 255) & ~(size_t)255; }
constexpr size_t OFF_BAR = 0;
constexpr size_t OFF_XC = ws_au(OFF_BAR + (size_t)3456 * 4);
constexpr size_t OFF_MODS = ws_au(OFF_XC + (size_t)NC * D * 4);
constexpr size_t OFF_S5P = ws_au(OFF_MODS + (size_t)2 * 9 * 9216 * 4);
constexpr size_t OFF_S5F = ws_au(OFF_S5P + (size_t)128 * 2304 * 4);
constexpr size_t OFF_S5PB = ws_au(OFF_S5F + (size_t)NB * 32 * 2 * NCH * 64 * 8);
constexpr size_t OFF_S5PC = ws_au(OFF_S5PB + (size_t)128 * 128 * 16 * 2);
constexpr size_t OFF_RK = ws_au(OFF_S5PC + (size_t)2 * 32 * 16 * 256 * 2);
constexpr size_t OFF_H = ws_au(OFF_RK + (size_t)2 * RK_LAYER * 2);
constexpr size_t OFF_WM = ws_au(OFF_H + (size_t)NT * D * 2);
constexpr size_t OFF_R = ws_au(OFF_WM + (size_t)12582912 * 2);
constexpr size_t OFF_HID = OFF_R;
constexpr size_t OFF_Y = OFF_R + ws_au((size_t)NT * FH * 2);
constexpr size_t OFF_Z = OFF_R;
constexpr size_t OFF_Q = ws_au(OFF_Z + (size_t)NT * ZW * 2);
constexpr size_t OFF_KB = ws_au(OFF_Q + (size_t)NT * 768 * 2);
constexpr size_t OFF_VT = ws_au(OFF_KB + (size_t)NB * 4 * KEYS * 192 * 2);
constexpr size_t OFF_NVT = ws_au(OFF_VT + (size_t)NB * 4 * 128 * KEYS * 2);
constexpr size_t OFF_BRH = ws_au(OFF_NVT + (size_t)NB * 8 * 64 * KEYS * 2);
constexpr size_t OFF_ST = ws_au(OFF_BRH + (size_t)NT * 512 * 2);
constexpr size_t WS_TOTAL = ws_au(OFF_ST + (size_t)NB * 512 * KEYS * 2);

struct Params {
  const float *x, *c, *ctx, *c_ctx, *w_mod, *b_mod, *norm_g, *ffn_w_in, *ffn_w_out, *w_in, *mla_g_q, *mla_g_kv,
      *mla_w_uq, *mla_w_ukv, *na_rpb, *hy_conv_w, *hy_conv_b, *hy_bias, *hy_w1, *hy_b1, *hy_f1, *hy_w2, *hy_b2,
      *hy_f2, *hy_w3, *s5_lam_re, *s5_lam_im, *s5_log_dt, *s5_b_re, *s5_b_im, *s5_c_re, *s5_c_im, *s5_d, *s5_w_glu,
      *s5_b_glu, *w_branch, *w_out;
  float* out;
  unsigned char* ws;
  __device__ __forceinline__ unsigned* bar() const { return (unsigned*)(ws + OFF_BAR); }
  __device__ __forceinline__ float* xc() const { return (float*)(ws + OFF_XC); }
  __device__ __forceinline__ float* mods() const { return (float*)(ws + OFF_MODS); }
  __device__ __forceinline__ float* S5P() const { return (float*)(ws + OFF_S5P); }
  __device__ __forceinline__ float* S5F() const { return (float*)(ws + OFF_S5F); }
  __device__ __forceinline__ u16* S5PB() const { return (u16*)(ws + OFF_S5PB); }
  __device__ __forceinline__ u16* S5PC() const { return (u16*)(ws + OFF_S5PC); }
  __device__ __forceinline__ u16* RK() const { return (u16*)(ws + OFF_RK); }
  __device__ __forceinline__ u16* H() const { return (u16*)(ws + OFF_H); }
  __device__ __forceinline__ u16* WM() const { return (u16*)(ws + OFF_WM); }
  __device__ __forceinline__ u16* HID() const { return (u16*)(ws + OFF_HID); }
  __device__ __forceinline__ float* Y() const { return (float*)(ws + OFF_Y); }
  __device__ __forceinline__ u16* Z() const { return (u16*)(ws + OFF_Z); }
  __device__ __forceinline__ u16* Q() const { return (u16*)(ws + OFF_Q); }
  __device__ __forceinline__ u16* Kb() const { return (u16*)(ws + OFF_KB); }
  __device__ __forceinline__ u16* VT() const { return (u16*)(ws + OFF_VT); }
  __device__ __forceinline__ u16* NVT() const { return (u16*)(ws + OFF_NVT); }
  __device__ __forceinline__ u16* BRH() const { return (u16*)(ws + OFF_BRH); }
  __device__ __forceinline__ u16* ST() const { return (u16*)(ws + OFF_ST); }
  __device__ __forceinline__ u16* M() const { return (u16*)(ws + OFF_KB); }
  __device__ __forceinline__ u16* WF() const { return (u16*)(ws + OFF_NVT); }
};

DEV int tidx512() { int t = threadIdx.x; asm volatile("" : "+v"(t)); return t; }
DEV int tidx() { int t = threadIdx.x & 255; asm volatile("" : "+v"(t)); return t; }
typedef __bf16 hwbf16x2 __attribute__((ext_vector_type(2)));
DEV u16 f2bf(float f) { return __builtin_bit_cast(u16, (__bf16)f); }
DEV float bf2f(u16 h) { return __uint_as_float(((unsigned)h) << 16); }
DEV unsigned pack2(float a, float b) {
  const hwbf16x2 r = __builtin_convertvector(f32x2{a, b}, hwbf16x2);
  return __builtin_bit_cast(unsigned, r);
}
DEV float bflo(unsigned u) { return __uint_as_float(u << 16); }
DEV float bfhi(unsigned u) { return __uint_as_float(u & 0xffff0000u); }
DEV float wave_sum(float v) {
#pragma unroll
  for (int o = 32; o > 0; o >>= 1) v += __shfl_xor(v, o);
  return v;
}
DEV float sigmoidf_(float x) { return __builtin_amdgcn_rcpf(1.f + __expf(-x)); }
DEV float siluf_(float x) { return x * __builtin_amdgcn_rcpf(1.f + __expf(-x)); }

template <int NI, bool HEADMAP>
DEV void gemm_core(f32x4 (&acc)[4][NI], const u16* __restrict__ A, int lda, const u16* __restrict__ Bt,
                          int ldk, int K, int baseLo, int baseHi, int stepW, u16* sm, u16*  ) {
  constexpr int BN = NI * 32, HS = BN / 4, LDK = 72;
  constexpr int NBC = BN / 32;
  constexpr int STAGE = (128 + BN) * LDK;
  const int tid = tidx(), lane = tid & 63, w = tid >> 6, wm = w >> 1, wn = w & 1, q = lane & 15, g = lane >> 4;
  const int ar = tid >> 3, akc = tid & 7;
  const u16* Ap = A + (size_t)ar * lda + akc * 8;
  auto browp = [&](int i) __attribute__((always_inline)) {
    const int bn = ar + 32 * i;
    const int bwn = bn / (BN / 2), br = bn % (BN / 2);
    const int grow = (br < HS ? baseLo : baseHi) + bwn * stepW + (br % HS);
    return Bt + (size_t)grow * ldk + akc * 8;
  };
  const u16* Bp0 = browp(0);
  const u16* Bp1 = browp(1);
  const u16* Bp2 = browp(NBC > 2 ? 2 : 0);
  const u16* Bp3 = browp(NBC > 2 ? 3 : 0);
  u32x4 r0a0, r0a1, r0a2, r0a3, r0b0, r0b1, r0b2, r0b3, r1a0, r1a1, r1a2, r1a3, r1b0, r1b1, r1b2, r1b3;
  r0b2 = r0b3 = r1b2 = r1b3 = u32x4{0, 0, 0, 0};
#define GLOAD(R, k0_)                                                                        \
  {                                                                                          \
    const int k0__ = (k0_);                                                                  \
    const int ka = HEADMAP ? ((k0__ >> 7) * 192 + (k0__ & 127)) : k0__;                      \
    R##a0 = *(const u32x4*)(Ap + ka);                                                         \
    R##a1 = *(const u32x4*)(Ap + (size_t)32 * lda + ka);                                      \
    R##a2 = *(const u32x4*)(Ap + (size_t)64 * lda + ka);                                      \
    R##a3 = *(const u32x4*)(Ap + (size_t)96 * lda + ka);                                      \
    R##b0 = *(const u32x4*)(Bp0 + k0__);                                                      \
    R##b1 = *(const u32x4*)(Bp1 + k0__);                                                      \
    if constexpr (NBC > 2) {                                                                 \
      R##b2 = *(const u32x4*)(Bp2 + k0__);                                                    \
      R##b3 = *(const u32x4*)(Bp3 + k0__);                                                    \
    }                                                                                        \
  }
#define LSTORE(R, st)                                                                        \
  {                                                                                          \
    u16* d__ = (st) + ar * LDK + akc * 8;                                                    \
    *(u32x4*)(d__) = R##a0;                                                                   \
    *(u32x4*)(d__ + 32 * LDK) = R##a1;                                                        \
    *(u32x4*)(d__ + 64 * LDK) = R##a2;                                                        \
    *(u32x4*)(d__ + 96 * LDK) = R##a3;                                                        \
    *(u32x4*)(d__ + 128 * LDK) = R##b0;                                                       \
    *(u32x4*)(d__ + 160 * LDK) = R##b1;                                                       \
    if constexpr (NBC > 2) {                                                                 \
      *(u32x4*)(d__ + 192 * LDK) = R##b2;                                                     \
      *(u32x4*)(d__ + 224 * LDK) = R##b3;                                                     \
    }                                                                                        \
  }
  auto compute = [&](const u16* sa) __attribute__((always_inline)) {
    const u16* sb = sa + 128 * LDK;
#pragma unroll
    for (int kk = 0; kk < 2; kk++) {
      bf16x8 af[4], bfr[NI];
#pragma unroll
      for (int mi = 0; mi < 4; mi++) af[mi] = *(const bf16x8*)(sa + (wm * 64 + mi * 16 + q) * LDK + kk * 32 + g * 8);
#pragma unroll
      for (int ni = 0; ni < NI; ni++) bfr[ni] = *(const bf16x8*)(sb + (wn * (BN / 2) + ni * 16 + q) * LDK + kk * 32 + g * 8);
#pragma unroll
      for (int mi = 0; mi < 4; mi++)
#pragma unroll
        for (int ni = 0; ni < NI; ni++)
          acc[mi][ni] = __builtin_amdgcn_mfma_f32_16x16x32_bf16(bfr[ni], af[mi], acc[mi][ni], 0, 0, 0);
    }
  };
  const int nk = K >> 6;
  u16* st0 = sm;
  u16* st1 = sm + STAGE;
  const int klast = K - 64;
  GLOAD(r0, 0);
  GLOAD(r1, min(64, klast));
  LSTORE(r0, st0);
  __syncthreads();
  for (int kt = 0; kt < nk; kt += 2) {
    if (kt + 2 < nk) GLOAD(r0, (kt + 2) << 6);
    compute(st0);
    LSTORE(r1, st1);
    __syncthreads();
    if (kt + 3 < nk) GLOAD(r1, (kt + 3) << 6);
    compute(st1);
    LSTORE(r0, st0);
    __syncthreads();
  }
#undef GLOAD
#undef LSTORE
}

DEV void gemm_core2(f32x4 (&acc)[8][4], const u16* __restrict__ A, int lda, const u16* __restrict__ Bt, int ldk, int K,
                    int baseLo, int baseHi, int stepW, u16* sm) {
  constexpr int LDK = 40, STAGE = 384 * LDK;
  const int tid = tidx(), lane = tid & 63, w = tid >> 6, wm = w >> 1, wn = w & 1, q = lane & 15, g = lane >> 4;
  const int ar = tid >> 2, akc = tid & 3;
  const u16* Ap = A + (size_t)ar * lda + akc * 8;
  const int br_ = ar & 63;
  const int growl = ((br_ & 32) ? baseHi : baseLo) + (br_ & 31);
  const u16* Bp0 = Bt + (size_t)growl * ldk + akc * 8;
  const u16* Bp1 = Bt + (size_t)(growl + stepW) * ldk + akc * 8;
  u32x4 r0a0, r0a1, r0a2, r0a3, r0b0, r0b1, r1a0, r1a1, r1a2, r1a3, r1b0, r1b1;
#define GLOAD2(R, k0_)                                            \
  {                                                               \
    const int k0__ = (k0_);                                       \
    R##a0 = *(const u32x4*)(Ap + k0__);                           \
    R##a1 = *(const u32x4*)(Ap + (size_t)64 * lda + k0__);        \
    R##a2 = *(const u32x4*)(Ap + (size_t)128 * lda + k0__);       \
    R##a3 = *(const u32x4*)(Ap + (size_t)192 * lda + k0__);       \
    R##b0 = *(const u32x4*)(Bp0 + k0__);                          \
    R##b1 = *(const u32x4*)(Bp1 + k0__);                          \
  }
#define LSTORE2(R, st)                                            \
  {                                                               \
    u16* d__ = (st) + ar * LDK + akc * 8;                         \
    *(u32x4*)(d__) = R##a0;                                       \
    *(u32x4*)(d__ + 64 * LDK) = R##a1;                            \
    *(u32x4*)(d__ + 128 * LDK) = R##a2;                           \
    *(u32x4*)(d__ + 192 * LDK) = R##a3;                           \
    *(u32x4*)(d__ + 256 * LDK) = R##b0;                           \
    *(u32x4*)(d__ + 320 * LDK) = R##b1;                           \
  }
  auto compute = [&](const u16* sa) __attribute__((always_inline)) {
    const u16* sb = sa + 256 * LDK;
    const u16* sap = sa + (wm * 128 + q) * LDK + g * 8;
    bf16x8 bfr[4];
#pragma unroll
    for (int ni = 0; ni < 4; ni++) bfr[ni] = *(const bf16x8*)(sb + (wn * 64 + ni * 16 + q) * LDK + g * 8);
    bf16x8 af[8];
    af[0] = *(const bf16x8*)(sap);
    af[1] = *(const bf16x8*)(sap + 16 * LDK);
    __builtin_amdgcn_sched_barrier(0);
#pragma unroll
    for (int mi = 0; mi < 8; mi++) {
      if (mi + 2 < 8) af[mi + 2] = *(const bf16x8*)(sap + (mi + 2) * 16 * LDK);
#pragma unroll
      for (int ni = 0; ni < 4; ni++)
        acc[mi][ni] = __builtin_amdgcn_mfma_f32_16x16x32_bf16(bfr[ni], af[mi], acc[mi][ni], 0, 0, 0);
      __builtin_amdgcn_sched_barrier(0);
    }
  };
  const int nk = K >> 5;
  u16* st0 = sm;
  u16* st1 = sm + STAGE;
  const int klast = K - 32;
  GLOAD2(r0, 0);
  GLOAD2(r1, min(32, klast));
  LSTORE2(r0, st0);
  __syncthreads();
  for (int kt = 0; kt < nk; kt += 2) {
    GLOAD2(r0, min((kt + 2) << 5, klast));
    __builtin_amdgcn_sched_barrier(0);
    compute(st0);
    LSTORE2(r1, st1);
    __syncthreads();
    GLOAD2(r1, min((kt + 3) << 5, klast));
    __builtin_amdgcn_sched_barrier(0);
    compute(st1);
    LSTORE2(r0, st0);
    __syncthreads();
  }
#undef GLOAD2
#undef LSTORE2
}

DEV void zero_acc8(f32x4 (&acc)[8][4]) {
#pragma unroll
  for (int mi = 0; mi < 8; mi++)
#pragma unroll
    for (int ni = 0; ni < 4; ni++) acc[mi][ni] = f32x4{0.f, 0.f, 0.f, 0.f};
}

DEV void wconv_tile(const float* __restrict__ src, int ldn, u16* __restrict__ dst, int K, int t,
                           unsigned char* smem) {
  u16* sT = (u16*)smem;
  const int tid = tidx();
  const int nkt = K >> 6;
  const int k0 = (t % nkt) * 64, n0 = (t / nkt) * 64;
  const int kr = tid >> 4, n4 = tid & 15;
  float4 v[4];
#pragma unroll
  for (int i = 0; i < 4; i++) v[i] = *(const float4*)(src + (size_t)(k0 + kr + 16 * i) * ldn + n0 + n4 * 4);
  __syncthreads();
#pragma unroll
  for (int i = 0; i < 4; i++) {
    const int k = kr + 16 * i;
    sT[(n4 * 4 + 0) * 72 + k] = f2bf(v[i].x);
    sT[(n4 * 4 + 1) * 72 + k] = f2bf(v[i].y);
    sT[(n4 * 4 + 2) * 72 + k] = f2bf(v[i].z);
    sT[(n4 * 4 + 3) * 72 + k] = f2bf(v[i].w);
  }
  __syncthreads();
#pragma unroll
  for (int j = 0; j < 2; j++) {
    const int c = tid + j * 256;
    const int n = c >> 3, kc = c & 7;
    *(uint4*)(dst + (size_t)(n0 + n) * K + k0 + kc * 8) = *(const uint4*)(sT + n * 72 + kc * 8);
  }
}

constexpr size_t WM_WIN = 0, WM_UQ = 8454144, WM_UKV = 8650752, WM_GLU = 8912896, WM_BR = 9437184, WM_OUT = 11534336,
                 WM_ELEMS = 12582912;
constexpr size_t WF_IN = 0, WF_OUT = 5767168, WF_ELEMS = 8650752;
constexpr int WM_TILES = 3072, WF_TILES = 2112;

DEV void wconv_mixer(const Params& p, int layer, int t, unsigned char* smem) {
  if (t < 2064) { wconv_tile(p.w_in + (size_t)layer * 1024 * NIN, NIN, p.WM() + WM_WIN, 1024, t, smem); return; }
  t -= 2064;
  if (t < 48) { wconv_tile(p.mla_w_uq + (size_t)layer * 256 * 768, 768, p.WM() + WM_UQ, 256, t, smem); return; }
  t -= 48;
  if (t < 64) { wconv_tile(p.mla_w_ukv + (size_t)layer * 256 * 1024, 1024, p.WM() + WM_UKV, 256, t, smem); return; }
  t -= 64;
  if (t < 128) { wconv_tile(p.s5_w_glu + (size_t)layer * 512 * 1024, 1024, p.WM() + WM_GLU, 512, t, smem); return; }
  t -= 128;
  if (t < 512) {
    const int n = t >> 7;
    wconv_tile(p.w_branch + ((size_t)layer * 4 + n) * 512 * 1024, 1024, p.WM() + WM_BR + (size_t)n * 1024 * 512, 512, t & 127, smem);
    return;
  }
  t -= 512;
  wconv_tile(p.w_out + (size_t)layer * D * D, D, p.WM() + WM_OUT, 1024, t, smem);
}
DEV void wconv_ffn(const Params& p, int layer, int which, int t, unsigned char* smem) {
  u16* dst = p.WF() + (size_t)which * WF_ELEMS;
  if (t < 1408) wconv_tile(p.ffn_w_in + ((size_t)layer * 2 + which) * 1024 * 5632, 5632, dst + WF_IN, 1024, t, smem);
  else wconv_tile(p.ffn_w_out + ((size_t)layer * 2 + which) * FH * D, D, dst + WF_OUT, FH, t - 1408, smem);
}

template <int NI>
DEV void zero_acc(f32x4 (&acc)[4][NI]) {
#pragma unroll
  for (int mi = 0; mi < 4; mi++)
#pragma unroll
    for (int ni = 0; ni < NI; ni++) acc[mi][ni] = f32x4{0.f, 0.f, 0.f, 0.f};
}

DEV void row_bk(int r, int& b, int& key) {
  if (r < NL) {
    b = r >> 11;
    key = 256 + (r & 2047);
  } else {
    int rr = r - NL;
    b = rr >> 8;
    key = rr & 255;
  }
}
DEV float* xrow_ptr(const Params& p, int r) { return r < NL ? p.out + (size_t)r * D : p.xc() + (size_t)(r - NL) * D; }
DEV const float* mod_ptr(const Params& p, int layer, int r) {
  int m = r < NL ? (r >> 11) : 8;
  return p.mods() + ((size_t)layer * 9 + m) * 9216;
}

DEV void mods_task(const Params& p, int task, unsigned char* smem) {
  float* sAct = (float*)smem;
  float* sRed = sAct + 9 * 1024;
  const int layer = task / 144, cb = task % 144;
  const int tid = tidx();
  __syncthreads();
  for (int i = tid; i < 9 * 1024; i += 256) {
    int r = i >> 10, k = i & 1023;
    float v = r < 8 ? p.c[r * 1024 + k] : p.c_ctx[k];
    sAct[i] = siluf_(v);
  }
  __syncthreads();
  const int col = cb * 64 + (tid & 63), kg = tid >> 6;
  const float* W = p.w_mod + (size_t)layer * 1024 * 9216 + col;
  float acc[9];
#pragma unroll
  for (int r = 0; r < 9; r++) acc[r] = 0.f;
#pragma unroll 1
  for (int k = kg * 256; k < kg * 256 + 256; k += 32) {
    float wv[32];
#pragma unroll
    for (int j = 0; j < 32; j++) wv[j] = W[(size_t)(k + j) * 9216];
#pragma unroll
    for (int j = 0; j < 32; j++)
#pragma unroll
      for (int r = 0; r < 9; r++) acc[r] += sAct[r * 1024 + k + j] * wv[j];
  }
#pragma unroll
  for (int r = 0; r < 9; r++) sRed[(kg * 9 + r) * 64 + (tid & 63)] = acc[r];
  __syncthreads();
  for (int i = tid; i < 9 * 64; i += 256) {
    int r = i >> 6, cc = i & 63;
    float s = sRed[(0 * 9 + r) * 64 + cc] + sRed[(1 * 9 + r) * 64 + cc] + sRed[(2 * 9 + r) * 64 + cc] +
              sRed[(3 * 9 + r) * 64 + cc];
    int gc = cb * 64 + cc;
    p.mods()[((size_t)layer * 9 + r) * 9216 + gc] = s + p.b_mod[layer * 9216 + gc];
  }
}

DEV void s5pre_task(const Params& p, int task) {
  const int idx = task * 256 + tidx();
  const int pp = idx & 63, ldg = idx >> 6;
  float re = fminf(p.s5_lam_re[idx], -1e-4f), im = p.s5_lam_im[idx];
  float dt = expf(p.s5_log_dt[ldg]);
  float er = expf(re * dt), sn, cs;
  sincosf(im * dt, &sn, &cs);
  float lbr = er * cs, lbi = er * sn;
  float e32 = expf(32.f * re * dt), sn32, cs32;
  sincosf(32.f * im * dt, &sn32, &cs32);
  float nr = lbr - 1.f, ni = lbi, den = re * re + im * im;
  float qr = (nr * re + ni * im) / den, qi = (ni * re - nr * im) / den;
  float* o = p.S5P() + (size_t)ldg * 2304 + pp;
  o[0 * 64] = lbr;
  o[1 * 64] = lbi;
  o[2 * 64] = e32 * cs32;
  o[3 * 64] = e32 * sn32;
  const float* bre = p.s5_b_re + (size_t)idx * 16;
  const float* bim = p.s5_b_im + (size_t)idx * 16;
  {
    const int lyr = ldg >> 6, dirr = (ldg >> 5) & 1, gg_ = ldg & 31;
    const float* cre = p.s5_c_re + (size_t)ldg * 16 * 64 + pp;
    const float* cim = p.s5_c_im + (size_t)ldg * 16 * 64 + pp;
    u16* tc = p.S5PC() + ((size_t)(lyr * 32 + gg_) * 16) * 256 + dirr * 128 + pp;
    for (int h = 0; h < 16; h++) {
      tc[h * 256] = f2bf(cre[h * 64]);
      tc[h * 256 + 64] = f2bf(-cim[h * 64]);
    }
  }
  u16* tb_re = p.S5PB() + ((size_t)ldg * 128 + pp) * 16;
  u16* tb_im = p.S5PB() + ((size_t)ldg * 128 + 64 + pp) * 16;
  for (int h = 0; h < 16; h++) {
    float br = bre[h], bi = bim[h];
    const float vr = qr * br - qi * bi, vi = qr * bi + qi * br;
    o[(4 + h * 2) * 64] = vr;
    o[(5 + h * 2) * 64] = vi;
    tb_re[h] = f2bf(vr);
    tb_im[h] = f2bf(vi);
  }
}

DEV void hyfilt_task(const Params& p, int task, unsigned char* smem) {
  float* sz = (float*)smem;
  float* h1 = sz + 8 * 33;
  float* h2 = h1 + 8 * 64;
  const int layer = task / 288, tb = task % 288;
  const bool isctx = tb >= 256;
  const int L = isctx ? CTXL : SEQ;
  const int t0 = (isctx ? tb - 256 : tb) * 8;
  const int tid = tidx();
  __syncthreads();
  for (int i = tid; i < 8 * 33; i += 256) {
    int tl = i / 33, e = i % 33;
    float t = (float)(t0 + tl);
    float v;
    if (e == 0) v = t / (float)(L - 1);
    else {
      int bi = (e - 1) & 15;
      float band = 1e-4f + (float)bi * ((15.f - 1e-4f) / 15.f);
      float ang = (2.0f * 3.14159265358979323846f * t / (float)L) * band;
      v = (e <= 16) ? cosf(ang) : -sinf(ang);
    }
    sz[i] = v;
  }
  __syncthreads();
  const float* w1 = p.hy_w1 + layer * 33 * 64;
  for (int i = tid; i < 8 * 64; i += 256) {
    int tl = i >> 6, j = i & 63;
    float s = p.hy_b1[layer * 64 + j];
    for (int e = 0; e < 33; e++) s += sz[tl * 33 + e] * w1[e * 64 + j];
    h1[i] = sinf(p.hy_f1[layer * 64 + j] * s);
  }
  __syncthreads();
  const float* w2 = p.hy_w2 + layer * 64 * 64;
  for (int i = tid; i < 8 * 64; i += 256) {
    int tl = i >> 6, j = i & 63;
    float s = p.hy_b2[layer * 64 + j];
    for (int e = 0; e < 64; e++) s += h1[tl * 64 + e] * w2[e * 64 + j];
    h2[i] = sinf(p.hy_f2[layer * 64 + j] * s);
  }
  __syncthreads();
  const float* w3 = p.hy_w3 + (size_t)layer * 64 * 1024;
  const float max_decay = logf(1e-2f) / 0.3f, min_decay = logf(1e-2f) / 1.5f;
  u16* RKb = p.RK() + (size_t)layer * RK_LAYER + (isctx ? (size_t)512 * RKL : 0);
  const int RW = isctx ? RKC : RKL;
  const int Dm = L - 1;
  for (int cc = 0; cc < 2; cc++) {
    const int c = tid + cc * 256;
    float af[8], ab[8];
#pragma unroll
    for (int tl = 0; tl < 8; tl++) af[tl] = ab[tl] = 0.f;
    for (int e = 0; e < 64; e++) {
      float wf = w3[e * 1024 + c], wb = w3[e * 1024 + 512 + c];
#pragma unroll
      for (int tl = 0; tl < 8; tl++) {
        float hv = h2[tl * 64 + e];
        af[tl] += hv * wf;
        ab[tl] += hv * wb;
      }
    }
    float delta = fabsf(min_decay + (max_decay - min_decay) * ((float)c / 511.f));
    u16* rk = RKb + (size_t)c * RW;
#pragma unroll
    for (int tl = 0; tl < 8; tl++) {
      int t = t0 + tl;
      float t01 = (float)t / (float)(L - 1);
      float dec = expf(-t01 * delta);
      float vf = af[tl] * dec, vb = ab[tl] * dec;
      if (t == 0) {
        rk[Dm] = f2bf(vf + vb + p.hy_bias[layer * 512 + c]);
        rk[2 * L - 1] = 0;
      } else {
        rk[Dm - t] = f2bf(vf);
        rk[Dm + t] = f2bf(vb);
      }
    }
  }
}

DEV void write_h_row(const Params& p, int r, const float (&xv)[16], int layer, int gidx, int shift_c, int scale_c) {
  const int lane = tidx() & 63;
  float ss = 0.f;
#pragma unroll
  for (int i = 0; i < 16; i++) ss += xv[i] * xv[i];
  ss = wave_sum(ss);
  const float rstd = rsqrtf(ss * (1.f / 1024.f) + EPS);
  const float* gg = p.norm_g + ((size_t)layer * 6 + gidx) * 1024;
  const float* md = mod_ptr(p, layer, r);
#pragma unroll
  for (int k = 0; k < 4; k++) {
    const int c0 = k * 256 + lane * 4;
    float4 g4 = *(const float4*)(gg + c0);
    float4 sh = *(const float4*)(md + shift_c * 1024 + c0);
    float4 sc = *(const float4*)(md + scale_c * 1024 + c0);
    float h0 = xv[k * 4 + 0] * rstd * g4.x * (1.f + sc.x) + sh.x;
    float h1 = xv[k * 4 + 1] * rstd * g4.y * (1.f + sc.y) + sh.y;
    float h2 = xv[k * 4 + 2] * rstd * g4.z * (1.f + sc.z) + sh.z;
    float h3 = xv[k * 4 + 3] * rstd * g4.w * (1.f + sc.w) + sh.w;
    uint2 o;
    o.x = pack2(h0, h1);
    o.y = pack2(h2, h3);
    *(uint2*)(p.H() + (size_t)r * D + c0) = o;
  }
}

DEV const float* xin_ptr(const Params& p, int r) { return r < NL ? p.x + (size_t)r * D : p.ctx + (size_t)(r - NL) * D; }
DEV void norm1_row(const Params& p, int r) {
  const int lane = tidx() & 63;
  const float* xr = xin_ptr(p, r);
  float xv[16];
#pragma unroll
  for (int k = 0; k < 4; k++) {
    float4 v = *(const float4*)(xr + k * 256 + lane * 4);
    xv[k * 4 + 0] = v.x; xv[k * 4 + 1] = v.y; xv[k * 4 + 2] = v.z; xv[k * 4 + 3] = v.w;
  }
  write_h_row(p, r, xv, 0, 0, 0, 1);
}

DEV void resid_row(const Params& p, int r, int layer, float coef, int gate_c, int gpost, bool wh, int nlayer,
                          int gnext, int shift_c, int scale_c, bool dry = false, bool from_input = false) {
  const int lane = tidx() & 63;
  float* xr = xrow_ptr(p, r);
  const float* xsrc = from_input ? xin_ptr(p, r) : xr;
  const u16* yr = (const u16*)p.Y() + (size_t)r * D;
  float yv[16], xv[16];
  float ss = 0.f;
#pragma unroll
  for (int k = 0; k < 4; k++) {
    const uint2 v = *(const uint2*)(yr + k * 256 + lane * 4);
    const float y0 = bflo(v.x), y1 = bfhi(v.x), y2 = bflo(v.y), y3 = bfhi(v.y);
    yv[k * 4 + 0] = y0; yv[k * 4 + 1] = y1; yv[k * 4 + 2] = y2; yv[k * 4 + 3] = y3;
    ss += y0 * y0 + y1 * y1 + y2 * y2 + y3 * y3;
  }
  ss = wave_sum(ss);
  const float rstd = rsqrtf(ss * (1.f / 1024.f) + EPS);
  const float* gg = p.norm_g + ((size_t)layer * 6 + gpost) * 1024;
  const float* md = mod_ptr(p, layer, r);
#pragma unroll
  for (int k = 0; k < 4; k++) {
    const int c0 = k * 256 + lane * 4;
    float4 xx = *(const float4*)(xsrc + c0);
    float4 g4 = *(const float4*)(gg + c0);
    float4 gt = *(const float4*)(md + gate_c * 1024 + c0);
    xx.x += coef * gt.x * (yv[k * 4 + 0] * rstd * g4.x);
    xx.y += coef * gt.y * (yv[k * 4 + 1] * rstd * g4.y);
    xx.z += coef * gt.z * (yv[k * 4 + 2] * rstd * g4.z);
    xx.w += coef * gt.w * (yv[k * 4 + 3] * rstd * g4.w);
    if (!dry) *(float4*)(xr + c0) = xx;
    xv[k * 4 + 0] = xx.x; xv[k * 4 + 1] = xx.y; xv[k * 4 + 2] = xx.z; xv[k * 4 + 3] = xx.w;
  }
  if (wh && !dry) write_h_row(p, r, xv, nlayer, gnext, shift_c, scale_c);
}

DEV void ffn_in_tile(const Params& p, int layer, int which, int tile, int MT, unsigned char* smem) {
  const int mt = tile % MT, nt = tile / MT;
  const int m0 = mt * 256, j0 = nt * 64;
  f32x4 acc[8][4];
  zero_acc8(acc);
  const u16* W = p.WF() + (size_t)which * WF_ELEMS + WF_IN;
  gemm_core2(acc, p.H() + (size_t)m0 * D, D, W, 1024, 1024, j0, FH + j0, 32, (u16*)smem);
  const int lane = tidx() & 63, w = tidx() >> 6, wm = w >> 1, wn = w & 1, q = lane & 15, g = lane >> 4;
#pragma unroll
  for (int mi = 0; mi < 8; mi++) {
    const int tok = m0 + wm * 128 + mi * 16 + q;
#pragma unroll
    for (int ni = 0; ni < 2; ni++) {
      f32x4 a = acc[mi][ni], b = acc[mi][ni + 2];
      const int col = j0 + wn * 32 + ni * 16 + g * 4;
      uint2 o;
      o.x = pack2(siluf_(a[0]) * b[0], siluf_(a[1]) * b[1]);
      o.y = pack2(siluf_(a[2]) * b[2], siluf_(a[3]) * b[3]);
      *(uint2*)(p.HID() + (size_t)tok * FH + col) = o;
    }
  }
}

DEV void gemm_f32out_tile(const Params& p, const u16* A, int lda, const u16* W, int ldb, int K, int tile,
                                 int MT, unsigned char* smem) {
  const int mt = tile % MT, nt = tile / MT;
  const int m0 = mt * 256, n0 = nt * 128;
  f32x4 acc[8][4];
  zero_acc8(acc);
  gemm_core2(acc, A + (size_t)m0 * lda, lda, W, ldb, K, n0, n0 + 32, 64, (u16*)smem);
  const int lane = tidx() & 63, w = tidx() >> 6, wm = w >> 1, wn = w & 1, q = lane & 15, g = lane >> 4;
#pragma unroll
  for (int mi = 0; mi < 8; mi++) {
    const int tok = m0 + wm * 128 + mi * 16 + q;
#pragma unroll
    for (int ni = 0; ni < 4; ni++) {
      const int col = n0 + wn * 64 + ni * 16 + g * 4;
      f32x4 a = acc[mi][ni];
      *(float4*)(p.Y() + (size_t)tok * D + col) = make_float4(a[0], a[1], a[2], a[3]);
    }
  }
}

DEV void inproj_tile(const Params& p, int layer, int tile, int MT, unsigned char* smem) {
  const int mt = tile % MT, nt = tile / MT;
  const int m0 = mt * 256, n0 = nt * 128;
  f32x4 acc[8][4];
  zero_acc8(acc);
  const u16* W = p.WM() + WM_WIN;
  gemm_core2(acc, p.H() + (size_t)m0 * D, D, W, 1024, 1024, n0, n0 + 32, 64, (u16*)smem);
  const int lane = tidx() & 63, w = tidx() >> 6, wm = w >> 1, wn = w & 1, q = lane & 15, g = lane >> 4;
#pragma unroll
  for (int mi = 0; mi < 8; mi++) {
    const int tok = m0 + wm * 128 + mi * 16 + q;
    int b, key;
    row_bk(tok, b, key);
#pragma unroll
    for (int ni = 0; ni < 4; ni++) {
      const int col = n0 + wn * 64 + ni * 16 + g * 4;
      f32x4 a = acc[mi][ni];
      uint2 o;
      o.x = pack2(a[0], a[1]);
      o.y = pack2(a[2], a[3]);
      *(uint2*)(p.Z() + (size_t)tok * ZW + col) = o;
      if (col >= C_NV && col < C_U) {
        const int hh = (col - C_NV) >> 6, e = (col - C_NV) & 63;
        u16* dst = p.NVT() + ((size_t)(b * 8 + hh) * 64 + e) * KEYS + key;
        dst[0] = (u16)(o.x & 0xffff);
        dst[KEYS] = (u16)(o.x >> 16);
        dst[2 * KEYS] = (u16)(o.y & 0xffff);
        dst[3 * KEYS] = (u16)(o.y >> 16);
      }
    }
  }
}

DEV void kvup_tile(const Params& p, int layer, int tile, int MT, unsigned char* smem) {
  u16* sA = (u16*)smem;
  u16* sB = sA + 128 * 40;
  const int mt = tile % MT, nt = tile / MT;
  const int m0 = mt * 128, n0 = nt * 128;
  f32x4 acc[4][4];
  zero_acc<4>(acc);
  const u16* W = p.WM() + WM_UKV;
  gemm_core<4, false>(acc, p.Z() + (size_t)m0 * ZW + C_CKV, ZW, W, 256, 256, n0, n0 + 32, 64, sA, sB);
  const int lane = tidx() & 63, w = tidx() >> 6, wm = w >> 1, wn = w & 1, q = lane & 15, g = lane >> 4;
#pragma unroll
  for (int mi = 0; mi < 4; mi++) {
    const int tok = m0 + wm * 64 + mi * 16 + q;
    int b, key;
    row_bk(tok, b, key);
#pragma unroll
    for (int ni = 0; ni < 4; ni++) {
      const int col = n0 + wn * 64 + ni * 16 + g * 4;
      const int hh = col >> 8, e = col & 255;
      f32x4 a = acc[mi][ni];
      uint2 o;
      o.x = pack2(a[0], a[1]);
      o.y = pack2(a[2], a[3]);
      if (e < 128) {
        *(uint2*)(p.Kb() + ((size_t)(b * 4 + hh) * KEYS + key) * 192 + e) = o;
      } else {
        u16* dst = p.VT() + ((size_t)(b * 4 + hh) * 128 + (e - 128)) * KEYS + key;
        dst[0] = (u16)(o.x & 0xffff);
        dst[KEYS] = (u16)(o.x >> 16);
        dst[2 * KEYS] = (u16)(o.y & 0xffff);
        dst[3 * KEYS] = (u16)(o.y >> 16);
      }
    }
  }
}

DEV void qup_tile(const Params& p, int layer, int tile, int MT, unsigned char* smem) {
  u16* sA = (u16*)smem;
  u16* sB = sA + 128 * 40;
  const int mt = tile % MT, nt = tile / MT;
  const int m0 = mt * 128, n0 = nt * 128;
  f32x4 acc[4][4];
  zero_acc<4>(acc);
  const u16* W = p.WM() + WM_UQ;
  gemm_core<4, false>(acc, p.Z() + (size_t)m0 * ZW + C_CQ, ZW, W, 256, 256, n0, n0 + 32, 64, sA, sB);
  const int lane = tidx() & 63, w = tidx() >> 6, wm = w >> 1, wn = w & 1, q = lane & 15, g = lane >> 4;
  const int cb = n0 + wn * 64;
  const bool ropeblk = (cb % 192) == 128;
#pragma unroll
  for (int mi = 0; mi < 4; mi++) {
    const int tok = m0 + wm * 64 + mi * 16 + q;
    f32x4 a0 = acc[mi][0], a1 = acc[mi][1], a2 = acc[mi][2], a3 = acc[mi][3];
    if (ropeblk && tok < NL) {
      const int t = tok & 2047;
      const float prow = (float)(t >> 6), pcol = (float)(t & 63);
#pragma unroll
      for (int j = 0; j < 4; j++) {
        const float inv = expf(-(float)(g * 4 + j) * (9.210340371976184f / 16.f));
        float sn, cs;
        sincosf(prow * inv, &sn, &cs);
        float x1 = a0[j], x2 = a1[j];
        a0[j] = x1 * cs - x2 * sn;
        a1[j] = x2 * cs + x1 * sn;
        sincosf(pcol * inv, &sn, &cs);
        x1 = a2[j]; x2 = a3[j];
        a2[j] = x1 * cs - x2 * sn;
        a3[j] = x2 * cs + x1 * sn;
      }
    }
    u16* dst = p.Q() + (size_t)tok * 768 + cb + g * 4;
    uint2 o;
    o.x = pack2(a0[0], a0[1]); o.y = pack2(a0[2], a0[3]);
    *(uint2*)(dst) = o;
    o.x = pack2(a1[0], a1[1]); o.y = pack2(a1[2], a1[3]);
    *(uint2*)(dst + 16) = o;
    o.x = pack2(a2[0], a2[1]); o.y = pack2(a2[2], a2[3]);
    *(uint2*)(dst + 32) = o;
    o.x = pack2(a3[0], a3[1]); o.y = pack2(a3[2], a3[3]);
    *(uint2*)(dst + 48) = o;
  }
}

DEV void glu_tile(const Params& p, int layer, int tile, int MT, unsigned char* smem) {
  u16* sA = (u16*)smem;
  u16* sB = sA + 128 * 40;
  const int mt = tile % MT, nt = tile / MT;
  const int m0 = mt * 128, j0 = nt * 64;
  f32x4 acc[4][4];
  zero_acc<4>(acc);
  const u16* W = p.WM() + WM_GLU;
  gemm_core<4, false>(acc, p.Z() + (size_t)m0 * ZW + C_U, ZW, W, 512, 512, j0, 512 + j0, 32, sA, sB);
  const int lane = tidx() & 63, w = tidx() >> 6, wm = w >> 1, wn = w & 1, q = lane & 15, g = lane >> 4;
  const float* bg = p.s5_b_glu + layer * 1024;
#pragma unroll
  for (int mi = 0; mi < 4; mi++) {
    const int tok = m0 + wm * 64 + mi * 16 + q;
#pragma unroll
    for (int ni = 0; ni < 2; ni++) {
      f32x4 a = acc[mi][ni], b = acc[mi][ni + 2];
      const int col = j0 + wn * 32 + ni * 16 + g * 4;
      float r[4];
#pragma unroll
      for (int j = 0; j < 4; j++) r[j] = (a[j] + bg[col + j]) * sigmoidf_(b[j] + bg[512 + col + j]);
      uint2 o;
      o.x = pack2(r[0], r[1]);
      o.y = pack2(r[2], r[3]);
      *(uint2*)(p.Z() + (size_t)tok * ZW + C_HY + col) = o;
    }
  }
}

DEV unsigned char* gate_ptr(const Params& p, int n, int tok) {
  if (n == 0) return (unsigned char*)p.NVT() + (size_t)tok * 1024;
  if (n == 1) return (unsigned char*)p.ST() + (size_t)tok * 1024;
  if (n == 2) return (unsigned char*)p.S5F() + (size_t)tok * 1024;
  return (unsigned char*)p.Z() + (size_t)tok * (ZW * 2);
}

DEV void merge_tile(const Params& p, int layer, int tile, int MT, unsigned char* smem) {
  u16* sA = (u16*)smem;
  const int mt = tile % MT, nt = tile / MT;
  const int m0 = mt * 128, n0 = nt * 128;
  const int lane = tidx() & 63, w = tidx() >> 6, wm = w >> 1, wn = w & 1, q = lane & 15, g = lane >> 4;
  unsigned mp[4][4][2];
#pragma unroll
  for (int mi = 0; mi < 4; mi++)
#pragma unroll
    for (int ni = 0; ni < 4; ni++) mp[mi][ni][0] = mp[mi][ni][1] = 0u;
  const u16* Wb = p.WM() + WM_BR;
#pragma unroll 1
  for (int n = 0; n < 4; n++) {
    f32x4 pa[4][4];
    zero_acc<4>(pa);
    const u16* wbn = Wb + (size_t)n * 1024 * 512;
    if (n == 0) gemm_core<4, true>(pa, p.Q() + (size_t)m0 * 768, 768, wbn, 512, 512, n0, n0 + 32, 64, sA, sA);
    else if (n == 1) gemm_core<4, false>(pa, p.BRH() + (size_t)m0 * 512, 512, wbn, 512, 512, n0, n0 + 32, 64, sA, sA);
    else if (n == 2) gemm_core<4, false>(pa, p.Z() + (size_t)m0 * ZW + C_HY, ZW, wbn, 512, 512, n0, n0 + 32, 64, sA, sA);
    else gemm_core<4, false>(pa, p.Z() + (size_t)m0 * ZW + C_NQ, ZW, wbn, 512, 512, n0, n0 + 32, 64, sA, sA);
#pragma unroll
    for (int mi = 0; mi < 4; mi++) {
      const int tok = m0 + wm * 64 + mi * 16 + q;
      const unsigned char* gp = gate_ptr(p, n, tok) + n0 + wn * 64 + g * 4;
#pragma unroll
      for (int ni = 0; ni < 4; ni++) {
        const unsigned gv = *(const unsigned*)(gp + ni * 16);
        const float r0 = bflo(mp[mi][ni][0]) + (float)(gv & 255u) * (1.f / 255.f) * pa[mi][ni][0];
        const float r1 = bfhi(mp[mi][ni][0]) + (float)((gv >> 8) & 255u) * (1.f / 255.f) * pa[mi][ni][1];
        const float r2 = bflo(mp[mi][ni][1]) + (float)((gv >> 16) & 255u) * (1.f / 255.f) * pa[mi][ni][2];
        const float r3 = bfhi(mp[mi][ni][1]) + (float)(gv >> 24) * (1.f / 255.f) * pa[mi][ni][3];
        mp[mi][ni][0] = pack2(r0, r1);
        mp[mi][ni][1] = pack2(r2, r3);
      }
    }
  }
#pragma unroll
  for (int mi = 0; mi < 4; mi++) {
    const int tok = m0 + wm * 64 + mi * 16 + q;
#pragma unroll
    for (int ni = 0; ni < 4; ni++) {
      const int col = n0 + wn * 64 + ni * 16 + g * 4;
      uint2 o;
      o.x = mp[mi][ni][0];
      o.y = mp[mi][ni][1];
      *(uint2*)(p.M() + (size_t)tok * D + col) = o;
    }
  }
}

constexpr int G8_BK = 64, G8_HT = 128 * G8_BK;
DEV int g8_lds_byte(int r, int c) {
  int st = (r >> 4) * 2 + (c >> 5), rr = r & 15, cc = c & 31, ob = rr * 64 + cc * 2;
  return st * 1024 + (ob ^ (((ob >> 9) & 1) << 5));
}
DEV void g8_stage_rc(int b, int& R, int& C) {
  int st = b / 1024, sb = b % 1024, swz = sb ^ (((sb >> 9) & 1) << 5);
  R = (st >> 1) * 16 + swz / 64;
  C = (st & 1) * 32 + (swz % 64) / 2;
}
DEV void gemm8_core(f32x4 (&acc)[2][2][4][2], const u16* __restrict__ A, const u16* __restrict__ Bt, int K, int brow,
                    int bcol0, int bcol1, u16* shm) {
#define G8_SA(b, h) (shm + ((b) * 2 + (h)) * G8_HT)
#define G8_SB(b, h) (shm + (4 + (b) * 2 + (h)) * G8_HT)
#define G8_STAGE(P, RS, br, kt)                                                                            \
  do {                                                                                                     \
    const int _so = (int)((((long)(br) * K + (long)(kt) * G8_BK)) * 2);                                    \
    __builtin_amdgcn_raw_ptr_buffer_load_lds(RS, (__attribute__((address_space(3))) unsigned*)((char*)(P) + g8_b0), 16, \
                                             g8_so0, _so, 0, 0);                                           \
    __builtin_amdgcn_raw_ptr_buffer_load_lds(RS, (__attribute__((address_space(3))) unsigned*)((char*)(P) + g8_b0 + 8192), \
                                             16, g8_so1, _so, 0, 0);                                       \
  } while (0)
#define G8_LDA(dst, b, h)                                                                                  \
  for (int m = 0; m < 4; ++m)                                                                              \
    for (int k = 0; k < 2; ++k)                                                                            \
      dst[m][k] = *reinterpret_cast<const bf16x8*>((char*)G8_SA(b, h) + g8_lds_byte(wr * 64 + m * 16 + fr, k * 32 + fq * 8))
#define G8_LDB(dst, b, h)                                                                                  \
  for (int n = 0; n < 2; ++n)                                                                              \
    for (int k = 0; k < 2; ++k)                                                                            \
      dst[n][k] = *reinterpret_cast<const bf16x8*>((char*)G8_SB(b, h) + g8_lds_byte(wc * 32 + n * 16 + fr, k * 32 + fq * 8))
#define G8_MMA(ai, bj, At_, Bt_)                                                                           \
  do {                                                                                                     \
    __builtin_amdgcn_s_setprio(1);                                                                         \
    for (int m = 0; m < 4; ++m)                                                                            \
      for (int n = 0; n < 2; ++n)                                                                          \
        for (int k = 0; k < 2; ++k)                                                                        \
          acc[ai][bj][m][n] = __builtin_amdgcn_mfma_f32_16x16x32_bf16(Bt_[n][k], At_[m][k], acc[ai][bj][m][n], 0, 0, 0); \
    __builtin_amdgcn_s_setprio(0);                                                                         \
  } while (0)
#define G8_WAIT_V(n) asm volatile("s_waitcnt vmcnt(" #n ")" ::: "memory")
#define G8_WAIT_L(n) asm volatile("s_waitcnt lgkmcnt(" #n ")" ::: "memory")
#define G8_BAR __builtin_amdgcn_s_barrier()
#define G8_SCHED __builtin_amdgcn_sched_barrier(0)
  const int tx = tidx512();
  const int wid = tx >> 6, lane = tx & 63, wr = wid >> 2, wc = wid & 3, fr = lane & 15, fq = lane >> 4;
  const int g8_b0 = tx * 16;
  unsigned g8_so0, g8_so1;
  {
    int r_, c_;
    g8_stage_rc(g8_b0, r_, c_);
    g8_so0 = (unsigned)(r_ * K + c_) * 2u;
    g8_stage_rc(g8_b0 + 8192, r_, c_);
    g8_so1 = (unsigned)(r_ * K + c_) * 2u;
  }
  const __amdgpu_buffer_rsrc_t rsA = __builtin_amdgcn_make_buffer_rsrc((void*)A, (short)0, 0x7ffffff0, 0x00020000);
  const __amdgpu_buffer_rsrc_t rsB = __builtin_amdgcn_make_buffer_rsrc((void*)Bt, (short)0, 0x7ffffff0, 0x00020000);
  bf16x8 At[4][2], B0[2][2], B1[2][2];
  const int nt = K / G8_BK;
  G8_STAGE(G8_SB(0, 0), rsB, bcol0, 0); G8_STAGE(G8_SA(0, 0), rsA, brow, 0);
  G8_STAGE(G8_SB(0, 1), rsB, bcol1, 0); G8_STAGE(G8_SA(0, 1), rsA, brow + 128, 0);
  if (wr == 1) G8_BAR;
  G8_WAIT_V(4); G8_BAR;
  G8_STAGE(G8_SB(1, 0), rsB, bcol0, 1); G8_STAGE(G8_SA(1, 0), rsA, brow, 1); G8_STAGE(G8_SB(1, 1), rsB, bcol1, 1);
  G8_WAIT_V(6); G8_BAR;
#pragma unroll 1
  for (int t = 0; t < nt - 2; t += 2) {
    G8_LDB(B0, 0, 0); G8_SCHED; G8_LDA(At, 0, 0); G8_STAGE(G8_SA(1, 1), rsA, brow + 128, t + 1);
    G8_WAIT_L(8); G8_BAR; G8_WAIT_L(0); G8_MMA(0, 0, At, B0); G8_BAR; G8_SCHED;
    G8_LDB(B1, 0, 1); G8_STAGE(G8_SB(0, 0), rsB, bcol0, t + 2);
    G8_BAR; G8_WAIT_L(0); G8_MMA(0, 1, At, B1); G8_BAR;
    G8_LDA(At, 0, 1); G8_STAGE(G8_SA(0, 0), rsA, brow, t + 2);
    G8_BAR; G8_WAIT_L(0); G8_MMA(1, 0, At, B0); G8_BAR; G8_SCHED;
    G8_STAGE(G8_SB(0, 1), rsB, bcol1, t + 2);
    G8_WAIT_V(6); G8_BAR; G8_MMA(1, 1, At, B1); G8_BAR;
    G8_LDB(B0, 1, 0); G8_SCHED; G8_LDA(At, 1, 0); G8_STAGE(G8_SA(0, 1), rsA, brow + 128, t + 2);
    G8_WAIT_L(8); G8_BAR; G8_WAIT_L(0); G8_MMA(0, 0, At, B0); G8_BAR; G8_SCHED;
    G8_LDB(B1, 1, 1); G8_STAGE(G8_SB(1, 0), rsB, bcol0, t + 3);
    G8_BAR; G8_WAIT_L(0); G8_MMA(0, 1, At, B1); G8_BAR;
    G8_LDA(At, 1, 1); G8_STAGE(G8_SA(1, 0), rsA, brow, t + 3);
    G8_BAR; G8_WAIT_L(0); G8_MMA(1, 0, At, B0); G8_BAR; G8_SCHED;
    G8_STAGE(G8_SB(1, 1), rsB, bcol1, t + 3);
    G8_WAIT_V(6); G8_BAR; G8_MMA(1, 1, At, B1); G8_BAR;
  }
  {
    G8_LDB(B0, 0, 0); G8_LDA(At, 0, 0); G8_STAGE(G8_SA(1, 1), rsA, brow + 128, nt - 1);
    G8_BAR; G8_WAIT_L(0); G8_MMA(0, 0, At, B0); G8_BAR;
    G8_LDB(B1, 0, 1); G8_BAR; G8_WAIT_L(0); G8_MMA(0, 1, At, B1); G8_BAR;
    G8_LDA(At, 0, 1); G8_WAIT_V(4); G8_BAR; G8_WAIT_L(0); G8_MMA(1, 0, At, B0); G8_MMA(1, 1, At, B1); G8_BAR;
  }
  {
    G8_LDB(B0, 1, 0); G8_LDA(At, 1, 0); G8_WAIT_V(2); G8_BAR; G8_WAIT_L(0); G8_MMA(0, 0, At, B0); G8_BAR;
    G8_LDB(B1, 1, 1); G8_WAIT_V(0); G8_BAR; G8_WAIT_L(0); G8_MMA(0, 1, At, B1); G8_BAR;
    G8_LDA(At, 1, 1); G8_BAR; G8_WAIT_L(0); G8_MMA(1, 0, At, B0); G8_MMA(1, 1, At, B1); G8_BAR;
  }
  if (wr == 0) G8_BAR;
#undef G8_SA
#undef G8_SB
#undef G8_STAGE
#undef G8_LDA
#undef G8_LDB
#undef G8_MMA
#undef G8_WAIT_V
#undef G8_WAIT_L
#undef G8_BAR
#undef G8_SCHED
}

DEV void g8_zero(f32x4 (&acc)[2][2][4][2]) {
#pragma unroll
  for (int a = 0; a < 2; a++)
#pragma unroll
    for (int b = 0; b < 2; b++)
#pragma unroll
      for (int m = 0; m < 4; m++)
#pragma unroll
        for (int n = 0; n < 2; n++) acc[a][b][m][n] = f32x4{0.f, 0.f, 0.f, 0.f};
}

DEV void ffn_in_tile8(const Params& p, int which, int tile, int MT, unsigned char* smem_all) {
  const int mt = tile % MT, nt = tile / MT;
  const int brow = mt * 256, j0 = nt * 128;
  f32x4 acc[2][2][4][2];
  g8_zero(acc);
  asm volatile("s_waitcnt vmcnt(0)" ::: "memory");
  __syncthreads();
  const u16* W = p.WF() + (size_t)which * WF_ELEMS + WF_IN;
  gemm8_core(acc, p.H(), W, 1024, brow, j0, FH + j0, (u16*)smem_all);
  const int tx = tidx512();
  const int wid = tx >> 6, lane = tx & 63, wr = wid >> 2, wc = wid & 3, fr = lane & 15, fq = lane >> 4;
#pragma unroll
  for (int ai = 0; ai < 2; ai++)
#pragma unroll
    for (int m = 0; m < 4; m++) {
      const int tok = brow + ai * 128 + wr * 64 + m * 16 + fr;
#pragma unroll
      for (int n = 0; n < 2; n++) {
        const f32x4 a = acc[ai][0][m][n], b = acc[ai][1][m][n];
        const int col = j0 + wc * 32 + n * 16 + fq * 4;
        uint2 o;
        o.x = pack2(siluf_(a[0]) * b[0], siluf_(a[1]) * b[1]);
        o.y = pack2(siluf_(a[2]) * b[2], siluf_(a[3]) * b[3]);
        *(uint2*)(p.HID() + (size_t)tok * FH + col) = o;
      }
    }
}

DEV void inproj_tile8(const Params& p, int tile, int MT, unsigned char* smem_all) {
  const int mt = tile % MT, nt = tile / MT;
  const int brow = mt * 256, n0 = nt * 256;
  f32x4 acc[2][2][4][2];
  g8_zero(acc);
  asm volatile("s_waitcnt vmcnt(0)" ::: "memory");
  __syncthreads();
  gemm8_core(acc, p.H(), p.WM() + WM_WIN, 1024, brow, n0, n0 + 128, (u16*)smem_all);
  const int tx = tidx512();
  const int wid = tx >> 6, lane = tx & 63, wr = wid >> 2, wc = wid & 3, fr = lane & 15, fq = lane >> 4;
#pragma unroll
  for (int ai = 0; ai < 2; ai++)
#pragma unroll
    for (int m = 0; m < 4; m++) {
      const int tok = brow + ai * 128 + wr * 64 + m * 16 + fr;
      int b, key;
      row_bk(tok, b, key);
#pragma unroll
      for (int bj = 0; bj < 2; bj++)
#pragma unroll
        for (int n = 0; n < 2; n++) {
          const int col = n0 + bj * 128 + wc * 32 + n * 16 + fq * 4;
          if (col < ZW) {
            const f32x4 a = acc[ai][bj][m][n];
            uint2 o;
            o.x = pack2(a[0], a[1]);
            o.y = pack2(a[2], a[3]);
            *(uint2*)(p.Z() + (size_t)tok * ZW + col) = o;
            if (col >= C_NV && col < C_U) {
              const int hh = (col - C_NV) >> 6, e = (col - C_NV) & 63;
              u16* dst = p.NVT() + ((size_t)(b * 8 + hh) * 64 + e) * KEYS + key;
              dst[0] = (u16)(o.x & 0xffff);
              dst[KEYS] = (u16)(o.x >> 16);
              dst[2 * KEYS] = (u16)(o.y & 0xffff);
              dst[3 * KEYS] = (u16)(o.y >> 16);
            }
          }
        }
    }
}

template <int K>
DEV void f32out_tile8(const Params& p, const u16* A, const u16* W, int tile, int MT, unsigned char* smem_all) {
  const int mt = tile % MT, nt = tile / MT;
  const int brow = mt * 256, n0 = nt * 256;
  f32x4 acc[2][2][4][2];
  g8_zero(acc);
  asm volatile("s_waitcnt vmcnt(0)" ::: "memory");
  __syncthreads();
  gemm8_core(acc, A, W, K, brow, n0, n0 + 128, (u16*)smem_all);
  const int tx = tidx512();
  const int wid = tx >> 6, lane = tx & 63, wr = wid >> 2, wc = wid & 3, fr = lane & 15, fq = lane >> 4;
#pragma unroll
  for (int ai = 0; ai < 2; ai++)
#pragma unroll
    for (int m = 0; m < 4; m++) {
      const int tok = brow + ai * 128 + wr * 64 + m * 16 + fr;
      u16* yrow = (u16*)p.Y() + (size_t)tok * D + n0 + wc * 32 + fq * 4;
#pragma unroll
      for (int bj = 0; bj < 2; bj++)
#pragma unroll
        for (int n = 0; n < 2; n++) {
          const f32x4 a = acc[ai][bj][m][n];
          uint2 o;
          o.x = pack2(a[0], a[1]);
          o.y = pack2(a[2], a[3]);
          *(uint2*)(yrow + bj * 128 + n * 16) = o;
        }
    }
}

DEV void gate_tile8(const Params& p, int tile, int MT, unsigned char* smem_all) {
  const int mt = tile % MT, nt = tile / MT;
  const int brow = mt * 256, n0 = nt * 256;
  f32x4 acc[2][2][4][2];
  g8_zero(acc);
  asm volatile("s_waitcnt vmcnt(0)" ::: "memory");
  __syncthreads();
  gemm8_core(acc, p.H(), p.WM() + WM_WIN, 1024, brow, C_GATE + n0, C_GATE + n0 + 128, (u16*)smem_all);
  const int tx = tidx512();
  const int wid = tx >> 6, lane = tx & 63, wr = wid >> 2, wc = wid & 3, fr = lane & 15, fq = lane >> 4;
  const int br_n = n0 >> 10, d0 = n0 & 1023;
#pragma unroll
  for (int ai = 0; ai < 2; ai++)
#pragma unroll
    for (int m = 0; m < 4; m++) {
      const int tok = brow + ai * 128 + wr * 64 + m * 16 + fr;
      unsigned char* gp = gate_ptr(p, br_n, tok) + d0 + wc * 32 + fq * 4;
#pragma unroll
      for (int bj = 0; bj < 2; bj++)
#pragma unroll
        for (int n = 0; n < 2; n++) {
          const f32x4 a = acc[ai][bj][m][n];
          const unsigned u0 = (unsigned)(sigmoidf_(a[0]) * 255.f + 0.5f), u1 = (unsigned)(sigmoidf_(a[1]) * 255.f + 0.5f);
          const unsigned u2 = (unsigned)(sigmoidf_(a[2]) * 255.f + 0.5f), u3 = (unsigned)(sigmoidf_(a[3]) * 255.f + 0.5f);
          *(unsigned*)(gp + bj * 128 + n * 16) = u0 | (u1 << 8) | (u2 << 16) | (u3 << 24);
        }
    }
}

DEV void mla_norm_row(const Params& p, int layer, int r, bool dry = false) {
  const int lane = tidx() & 63;
  u16* zr = p.Z() + (size_t)r * ZW;
  {
    uint2 v = *(const uint2*)(zr + C_CKV + lane * 4);
    float a0 = bflo(v.x), a1 = bfhi(v.x), a2 = bflo(v.y), a3 = bfhi(v.y);
    float ss = wave_sum(a0 * a0 + a1 * a1 + a2 * a2 + a3 * a3);
    float rstd = rsqrtf(ss * (1.f / 256.f) + EPS);
    float4 g4 = *(const float4*)(p.mla_g_kv + layer * 256 + lane * 4);
    uint2 o;
    o.x = pack2(a0 * rstd * g4.x, a1 * rstd * g4.y);
    o.y = pack2(a2 * rstd * g4.z, a3 * rstd * g4.w);
    if (!dry) *(uint2*)(zr + C_CKV + lane * 4) = o;
  }
  {
    uint2 v = *(const uint2*)(zr + C_CQ + lane * 4);
    float a0 = bflo(v.x), a1 = bfhi(v.x), a2 = bflo(v.y), a3 = bfhi(v.y);
    float ss = wave_sum(a0 * a0 + a1 * a1 + a2 * a2 + a3 * a3);
    float rstd = rsqrtf(ss * (1.f / 256.f) + EPS);
    float4 g4 = *(const float4*)(p.mla_g_q + layer * 256 + lane * 4);
    uint2 o;
    o.x = pack2(a0 * rstd * g4.x, a1 * rstd * g4.y);
    o.y = pack2(a2 * rstd * g4.z, a3 * rstd * g4.w);
    if (!dry) *(uint2*)(zr + C_CQ + lane * 4) = o;
  }
  {
    float xm = bf2f(zr[C_KR + lane]);
    float xo = __shfl_xor(xm, 16);
    float val = xm;
    if (r < NL) {
      const int t = r & 2047;
      const float pos = (lane & 32) ? (float)(t & 63) : (float)(t >> 6);
      const float inv = expf(-(float)(lane & 15) * (9.210340371976184f / 16.f));
      float sn, cs;
      sincosf(pos * inv, &sn, &cs);
      val = (lane & 16) ? (xm * cs + xo * sn) : (xm * cs - xo * sn);
    }
    int b, key;
    row_bk(r, b, key);
    const u16 hv = f2bf(val);
#pragma unroll
    for (int hh = 0; hh < 4; hh++) p.Kb()[((size_t)(b * 4 + hh) * KEYS + key) * 192 + 128 + lane] = hv;
  }
}

template <int DQK, int DV, class BiasF>
DEV void attn_group(const bf16x8 (&qf)[DQK / 32], f32x4 (&o)[DV / 16], float& m, float& l, const u16* k0p,
                    const u16* k1p, const u16* vt, int vts, float scale, BiasF bias) {
  const int lane = tidx() & 63, q = lane & 15, g = lane >> 4;
  f32x4 s0 = {0.f, 0.f, 0.f, 0.f}, s1 = {0.f, 0.f, 0.f, 0.f};
#pragma unroll
  for (int ds = 0; ds < DQK / 32; ds++) {
    bf16x8 kf0 = *(const bf16x8*)(k0p + ds * 32 + g * 8);
    bf16x8 kf1 = *(const bf16x8*)(k1p + ds * 32 + g * 8);
    s0 = __builtin_amdgcn_mfma_f32_16x16x32_bf16(kf0, qf[ds], s0, 0, 0, 0);
    s1 = __builtin_amdgcn_mfma_f32_16x16x32_bf16(kf1, qf[ds], s1, 0, 0, 0);
  }
  float sv[8];
#pragma unroll
  for (int j = 0; j < 4; j++) {
    sv[j] = s0[j] * scale + bias(g * 4 + j);
    sv[4 + j] = s1[j] * scale + bias(16 + g * 4 + j);
  }
  float mx = sv[0];
#pragma unroll
  for (int j = 1; j < 8; j++) mx = fmaxf(mx, sv[j]);
  mx = fmaxf(mx, __shfl_xor(mx, 16));
  mx = fmaxf(mx, __shfl_xor(mx, 32));
  const float mn = fmaxf(m, mx);
  const float alpha = __expf(m - mn);
  m = mn;
  float ps = 0.f;
  float pv[8];
#pragma unroll
  for (int j = 0; j < 8; j++) {
    pv[j] = __expf(sv[j] - mn);
    ps += pv[j];
  }
  l = l * alpha + ps;
  union { bf16x8 v; unsigned u[4]; } pf;
  pf.u[0] = pack2(pv[0], pv[1]);
  pf.u[1] = pack2(pv[2], pv[3]);
  pf.u[2] = pack2(pv[4], pv[5]);
  pf.u[3] = pack2(pv[6], pv[7]);
#pragma unroll
  for (int et = 0; et < DV / 16; et++) {
    const u16* vp = vt + (size_t)(et * 16 + q) * vts + g * 4;
    union { bf16x8 v; uint2 u[2]; } vf;
    vf.u[0] = *(const uint2*)(vp);
    vf.u[1] = *(const uint2*)(vp + 16);
    f32x4 oo = o[et];
    oo[0] *= alpha; oo[1] *= alpha; oo[2] *= alpha; oo[3] *= alpha;
    o[et] = __builtin_amdgcn_mfma_f32_16x16x32_bf16(vf.v, pf.v, oo, 0, 0, 0);
  }
}

template <int DV>
DEV void attn_store(const f32x4 (&o)[DV / 16], float l, u16* orow, bool dry = false) {
  const int lane = tidx() & 63, g = lane >> 4;
  l += __shfl_xor(l, 16);
  l += __shfl_xor(l, 32);
  const float inv = 1.f / l;
#pragma unroll
  for (int et = 0; et < DV / 16; et++) {
    uint2 ov;
    ov.x = pack2(o[et][0] * inv, o[et][1] * inv);
    ov.y = pack2(o[et][2] * inv, o[et][3] * inv);
    if (!dry) *(uint2*)(orow + et * 16 + g * 4) = ov;
  }
}

DEV void mla_attn_wave(const Params& p, int wt, bool dry = false) {
  const int lane = tidx() & 63, q = lane & 15, g = lane >> 4;
  int b, hh, row0, ngroups;
  if (wt < 4096) {
    const int qt = wt & 127;
    hh = (wt >> 7) & 3;
    b = wt >> 9;
    row0 = b * 2048 + qt * 16;
    ngroups = 72;
  } else {
    const int w2 = wt - 4096;
    const int qt = w2 & 15;
    hh = (w2 >> 4) & 3;
    b = w2 >> 6;
    row0 = NL + b * 256 + qt * 16;
    ngroups = 8;
  }
  u16* qrow = p.Q() + (size_t)(row0 + q) * 768 + hh * 192;
  bf16x8 qf[6];
#pragma unroll
  for (int ds = 0; ds < 6; ds++) qf[ds] = *(const bf16x8*)(qrow + ds * 32 + g * 8);
  f32x4 o[8];
#pragma unroll
  for (int et = 0; et < 8; et++) o[et] = f32x4{0.f, 0.f, 0.f, 0.f};
  float m = -INFINITY, l = 0.f;
  const u16* Kbase = p.Kb() + (size_t)(b * 4 + hh) * KEYS * 192;
  const u16* Vbase = p.VT() + (size_t)(b * 4 + hh) * 128 * KEYS;
  const float scale = 0.07216878364870322f;
  auto nobias = [](int) { return 0.f; };
  for (int kg = 0; kg < ngroups; kg++) {
    const int kb = kg * 32;
    attn_group<192, 128>(qf, o, m, l, Kbase + (size_t)(kb + q) * 192, Kbase + (size_t)(kb + 16 + q) * 192,
                         Vbase + kb, KEYS, scale, nobias);
  }
  attn_store<128>(o, l, qrow, dry);
}

DEV void softmax_step(const f32x4& s0, const f32x4& s1, float scale, float& m, float& l, bf16x8& pfo, float& alpha) {
  const float sc2 = scale * 1.4426950408889634f;
  float sv[8];
#pragma unroll
  for (int j = 0; j < 4; j++) {
    sv[j] = s0[j] * sc2;
    sv[4 + j] = s1[j] * sc2;
  }
  float mx = sv[0];
#pragma unroll
  for (int j = 1; j < 8; j++) mx = fmaxf(mx, sv[j]);
  mx = fmaxf(mx, __shfl_xor(mx, 16));
  mx = fmaxf(mx, __shfl_xor(mx, 32));
  const float mn = fmaxf(m, mx);
  alpha = __builtin_amdgcn_exp2f(m - mn);
  m = mn;
  float ps = 0.f, pv[8];
#pragma unroll
  for (int j = 0; j < 8; j++) {
    pv[j] = __builtin_amdgcn_exp2f(sv[j] - mn);
    ps += pv[j];
  }
  l = l * alpha + ps;
  union { bf16x8 v; unsigned u[4]; } pf;
  pf.u[0] = pack2(pv[0], pv[1]);
  pf.u[1] = pack2(pv[2], pv[3]);
  pf.u[2] = pack2(pv[4], pv[5]);
  pf.u[3] = pack2(pv[6], pv[7]);
  pfo = pf.v;
}

DEV void na_attn_block(const Params& p, int layer, int task, unsigned char* smem, bool dry) {
  constexpr int KS = 72, VS = 40;
  constexpr int STG = 32 * KS + 64 * VS;
  u16* sm = (u16*)smem;
  const int tid = tidx(), lane = tid & 63, w = tid >> 6, q = lane & 15, g = lane >> 4;
  const bool lat = task < 2048;
  int b, hh, gr = 0, row0;
  if (lat) {
    hh = task & 7; gr = (task >> 3) & 31; b = task >> 8;
    row0 = b * 2048 + gr * 64 + w * 16;
  } else {
    const int t2 = task - 2048;
    const int qb = t2 & 3;
    hh = (t2 >> 2) & 7; b = t2 >> 5;
    row0 = NL + b * 256 + qb * 64 + w * 16;
  }
  const int ng = lat ? 24 : 8;
  u16* qrow = p.Z() + (size_t)(row0 + q) * ZW + C_NQ + hh * 64;
  bf16x8 qf[2];
  qf[0] = *(const bf16x8*)(qrow + g * 8);
  qf[1] = *(const bf16x8*)(qrow + 32 + g * 8);
  f32x4 o[4];
#pragma unroll
  for (int et = 0; et < 4; et++) o[et] = f32x4{0.f, 0.f, 0.f, 0.f};
  float m = -INFINITY, l = 0.f;
  const u16* Vbase = p.NVT() + (size_t)(b * 8 + hh) * 64 * KEYS;
  const int rbase = min(max(gr - 4, 0), 24);
  const int qc = w * 16 + q;
  const int c0 = min(max(qc - 8, 0), 48);
  const int klo = min(max(w * 16 - 8, 0), 48), khi = min(max(w * 16 + 15 - 8, 0), 48) + 15;
  const float* rpb = p.na_rpb + ((size_t)layer * 8 + hh) * 15 * 31;
  const int krow_l = tid >> 3, kch = tid & 7, ve = tid >> 2, vch = tid & 3;
  u32x4 r0k, r0v, r1k, r1v;
#define NA_GLOAD(R, kg_)                                                                                    \
  {                                                                                                      \
    const int kg__ = (kg_);                                                                              \
    const int l2__ = kg__ - 8;                                                                           \
    const int tokb__ = (rbase + (l2__ >> 1)) * 64 + (l2__ & 1) * 32;                                     \
    const int rowb__ = kg__ < 8 ? NL + b * 256 + kg__ * 32 : b * 2048 + tokb__;                          \
    const int keyb__ = kg__ < 8 ? kg__ * 32 : 256 + tokb__;                                              \
    R##k = *(const u32x4*)(p.Z() + (size_t)(rowb__ + krow_l) * ZW + C_NK + hh * 64 + kch * 8);               \
    R##v = *(const u32x4*)(Vbase + (size_t)ve * KEYS + keyb__ + vch * 8);                                  \
  }
#define NA_LSTORE(R, st_)                                                                                   \
  {                                                                                                      \
    u16* st__ = (st_);                                                                                   \
    *(u32x4*)(st__ + krow_l * KS + kch * 8) = R##k;                                                        \
    *(u32x4*)(st__ + 32 * KS + ve * VS + vch * 8) = R##v;                                                  \
  }
  auto compute = [&](const int kg, const u16* sk) __attribute__((always_inline)) {
    const u16* sv = sk + 32 * KS;
    bool active = true;
    int kc0 = 0;
    const float* rp = rpb;
    if (kg >= 8) {
      const int l2 = kg - 8;
      kc0 = (l2 & 1) * 32;
      active = !(kc0 > khi || kc0 + 31 < klo);
      rp = rpb + (rbase + (l2 >> 1) - gr + 7) * 31;
    }
    if (active) {
      f32x4 s0 = {0.f, 0.f, 0.f, 0.f}, s1 = {0.f, 0.f, 0.f, 0.f};
#pragma unroll
      for (int ds = 0; ds < 2; ds++) {
        const bf16x8 kf0 = *(const bf16x8*)(sk + q * KS + ds * 32 + g * 8);
        const bf16x8 kf1 = *(const bf16x8*)(sk + (16 + q) * KS + ds * 32 + g * 8);
        s0 = __builtin_amdgcn_mfma_f32_16x16x32_bf16(kf0, qf[ds], s0, 0, 0, 0);
        s1 = __builtin_amdgcn_mfma_f32_16x16x32_bf16(kf1, qf[ds], s1, 0, 0, 0);
      }
      bf16x8 pf;
      float alpha;
      f32x4 bz0 = {0.f, 0.f, 0.f, 0.f}, bz1 = {0.f, 0.f, 0.f, 0.f};
      if (kg >= 8) {
#pragma unroll
        for (int j = 0; j < 4; j++) {
          const int ka = kc0 + g * 4 + j, kb2 = ka + 16;
          const float va = rp[min(max(ka - qc + 15, 0), 30)];
          const float vb = rp[min(max(kb2 - qc + 15, 0), 30)];
          bz0[j] = ((ka >= c0) && (ka < c0 + 16)) ? va : -INFINITY;
          bz1[j] = ((kb2 >= c0) && (kb2 < c0 + 16)) ? vb : -INFINITY;
        }
      }
      s0 = s0 * 0.125f + bz0;
      s1 = s1 * 0.125f + bz1;
      softmax_step(s0, s1, 1.0f, m, l, pf, alpha);
#pragma unroll
      for (int et = 0; et < 4; et++) {
        union { bf16x8 v; uint2 u[2]; } vf;
        vf.u[0] = *(const uint2*)(sv + (et * 16 + q) * VS + g * 4);
        vf.u[1] = *(const uint2*)(sv + (et * 16 + q) * VS + 16 + g * 4);
        f32x4 oo = o[et];
        oo[0] *= alpha; oo[1] *= alpha; oo[2] *= alpha; oo[3] *= alpha;
        o[et] = __builtin_amdgcn_mfma_f32_16x16x32_bf16(vf.v, pf, oo, 0, 0, 0);
      }
    }
  };
  __syncthreads();
  NA_GLOAD(r0, 0);
  NA_GLOAD(r1, 1);
  NA_LSTORE(r0, sm);
  __syncthreads();
#pragma unroll 1
  for (int kg = 0; kg < ng; kg += 2) {
    NA_GLOAD(r0, min(kg + 2, ng - 1));
    compute(kg, sm);
    NA_LSTORE(r1, sm + STG);
    __syncthreads();
    NA_GLOAD(r1, min(kg + 3, ng - 1));
    compute(kg + 1, sm + STG);
    NA_LSTORE(r0, sm);
    __syncthreads();
  }
  attn_store<64>(o, l, qrow, dry);
#undef NA_GLOAD
#undef NA_LSTORE
}

DEV void mla_attn_block(const Params& p, int task, unsigned char* smem, bool dry) {
  constexpr int KS = 200, VS = 40;
  constexpr int STG = 32 * KS + 128 * VS;
  u16* sm = (u16*)smem;
  const int tid = tidx(), lane = tid & 63, w = tid >> 6, q = lane & 15, g = lane >> 4;
  int b, hh, row0, ng;
  if (task < 512) {
    const int qb = task & 15;
    hh = (task >> 4) & 3;
    b = task >> 6;
    row0 = b * 2048 + qb * 128;
    ng = 72;
  } else {
    const int t2 = task - 512;
    const int qb = t2 & 1;
    hh = (t2 >> 1) & 3;
    b = t2 >> 3;
    row0 = NL + b * 256 + qb * 128;
    ng = 8;
  }
  u16* qrow0 = p.Q() + (size_t)(row0 + w * 32 + q) * 768 + hh * 192;
  u16* qrow1 = qrow0 + (size_t)16 * 768;
  bf16x8 qf[2][6];
#pragma unroll
  for (int ds = 0; ds < 6; ds++) {
    qf[0][ds] = *(const bf16x8*)(qrow0 + ds * 32 + g * 8);
    qf[1][ds] = *(const bf16x8*)(qrow1 + ds * 32 + g * 8);
  }
  f32x4 o[2][8];
#pragma unroll
  for (int qt = 0; qt < 2; qt++)
#pragma unroll
    for (int et = 0; et < 8; et++) o[qt][et] = f32x4{0.f, 0.f, 0.f, 0.f};
  float m[2] = {-INFINITY, -INFINITY}, l[2] = {0.f, 0.f};
  const u16* Kbase = p.Kb() + (size_t)(b * 4 + hh) * KEYS * 192;
  const u16* Vbase = p.VT() + (size_t)(b * 4 + hh) * 128 * KEYS;
  const float scale = 0.07216878364870322f;
  int krow[3], kch[3];
#pragma unroll
  for (int i = 0; i < 3; i++) {
    const int c = tid + i * 256;
    krow[i] = c / 24;
    kch[i] = c % 24;
  }
  const int ve0 = tid >> 2, vch = tid & 3;
  u32x4 r0k0, r0k1, r0k2, r0v0, r0v1, r1k0, r1k1, r1k2, r1v0, r1v1;
#define MLA_GL(R, kg_)                                                                           \
  {                                                                                              \
    const int kb__ = (kg_) * 32;                                                                 \
    R##k0 = *(const u32x4*)(Kbase + (size_t)(kb__ + krow[0]) * 192 + kch[0] * 8);                \
    R##k1 = *(const u32x4*)(Kbase + (size_t)(kb__ + krow[1]) * 192 + kch[1] * 8);                \
    R##k2 = *(const u32x4*)(Kbase + (size_t)(kb__ + krow[2]) * 192 + kch[2] * 8);                \
    R##v0 = *(const u32x4*)(Vbase + (size_t)ve0 * KEYS + kb__ + vch * 8);                        \
    R##v1 = *(const u32x4*)(Vbase + (size_t)(ve0 + 64) * KEYS + kb__ + vch * 8);                 \
  }
#define MLA_LS(R, st_)                                                                           \
  {                                                                                              \
    u16* st__ = (st_);                                                                           \
    *(u32x4*)(st__ + krow[0] * KS + kch[0] * 8) = R##k0;                                         \
    *(u32x4*)(st__ + krow[1] * KS + kch[1] * 8) = R##k1;                                         \
    *(u32x4*)(st__ + krow[2] * KS + kch[2] * 8) = R##k2;                                         \
    *(u32x4*)(st__ + 32 * KS + ve0 * VS + vch * 8) = R##v0;                                      \
    *(u32x4*)(st__ + 32 * KS + (ve0 + 64) * VS + vch * 8) = R##v1;                               \
  }
  auto compute = [&](const u16* sk) __attribute__((always_inline)) {
    const u16* sv = sk + 32 * KS;
    f32x4 s[2][2];
#pragma unroll
    for (int qt = 0; qt < 2; qt++) s[qt][0] = s[qt][1] = f32x4{0.f, 0.f, 0.f, 0.f};
#pragma unroll
    for (int ds = 0; ds < 6; ds++) {
      const bf16x8 kf0 = *(const bf16x8*)(sk + q * KS + ds * 32 + g * 8);
      const bf16x8 kf1 = *(const bf16x8*)(sk + (16 + q) * KS + ds * 32 + g * 8);
#pragma unroll
      for (int qt = 0; qt < 2; qt++) {
        s[qt][0] = __builtin_amdgcn_mfma_f32_16x16x32_bf16(kf0, qf[qt][ds], s[qt][0], 0, 0, 0);
        s[qt][1] = __builtin_amdgcn_mfma_f32_16x16x32_bf16(kf1, qf[qt][ds], s[qt][1], 0, 0, 0);
      }
    }
    bf16x8 pf[2];
    float alpha0, alpha1;
    softmax_step(s[0][0], s[0][1], scale, m[0], l[0], pf[0], alpha0);
    softmax_step(s[1][0], s[1][1], scale, m[1], l[1], pf[1], alpha1);
    if (__any((alpha0 != 1.f) || (alpha1 != 1.f))) {
#pragma unroll
      for (int et = 0; et < 8; et++) {
        o[0][et][0] *= alpha0; o[0][et][1] *= alpha0; o[0][et][2] *= alpha0; o[0][et][3] *= alpha0;
        o[1][et][0] *= alpha1; o[1][et][1] *= alpha1; o[1][et][2] *= alpha1; o[1][et][3] *= alpha1;
      }
    }
#pragma unroll
    for (int et = 0; et < 8; et++) {
      union { bf16x8 v; uint2 u[2]; } vf;
      vf.u[0] = *(const uint2*)(sv + (et * 16 + q) * VS + g * 4);
      vf.u[1] = *(const uint2*)(sv + (et * 16 + q) * VS + 16 + g * 4);
#pragma unroll
      for (int qt = 0; qt < 2; qt++) o[qt][et] = __builtin_amdgcn_mfma_f32_16x16x32_bf16(vf.v, pf[qt], o[qt][et], 0, 0, 0);
    }
  };
  __syncthreads();
  MLA_GL(r0, 0);
  MLA_GL(r1, 1);
  MLA_LS(r0, sm);
  __syncthreads();
#pragma unroll 1
  for (int kg = 0; kg < ng; kg += 2) {
    MLA_GL(r0, min(kg + 2, ng - 1));
    compute(sm);
    MLA_LS(r1, sm + STG);
    __syncthreads();
    MLA_GL(r1, min(kg + 3, ng - 1));
    compute(sm + STG);
    MLA_LS(r0, sm);
    __syncthreads();
  }
#undef MLA_GL
#undef MLA_LS
  attn_store<128>(o[0], l[0], qrow0, dry);
  attn_store<128>(o[1], l[1], qrow1, dry);
}

DEV void na_attn_wave(const Params& p, int layer, int wt, bool dry = false) {
  const int lane = tidx() & 63, q = lane & 15, g = lane >> 4;
  const float scale = 0.125f;
  auto nobias = [](int) { return 0.f; };
  f32x4 o[4];
#pragma unroll
  for (int et = 0; et < 4; et++) o[et] = f32x4{0.f, 0.f, 0.f, 0.f};
  float m = -INFINITY, l = 0.f;
  bf16x8 qf[2];
  if (wt < 8192) {
    const int qt = wt & 3, hh = (wt >> 2) & 7, gr = (wt >> 5) & 31, b = wt >> 10;
    const int row0 = b * 2048 + gr * 64 + qt * 16;
    u16* qrow = p.Z() + (size_t)(row0 + q) * ZW + C_NQ + hh * 64;
    qf[0] = *(const bf16x8*)(qrow + g * 8);
    qf[1] = *(const bf16x8*)(qrow + 32 + g * 8);
    const u16* Vbase = p.NVT() + (size_t)(b * 8 + hh) * 64 * KEYS;
    for (int kg = 0; kg < 8; kg++) {
      const int kb = kg * 32;
      const u16* k0p = p.Z() + (size_t)(NL + b * 256 + kb + q) * ZW + C_NK + hh * 64;
      attn_group<64, 64>(qf, o, m, l, k0p, k0p + (size_t)16 * ZW, Vbase + kb, KEYS, scale, nobias);
    }
    const int rbase = min(max(gr - 4, 0), 24);
    const int qc = qt * 16 + q;
    const int c0 = min(max(qc - 8, 0), 48);
    const int klo = min(max(qt * 16 - 8, 0), 48), khi = min(max(qt * 16 + 15 - 8, 0), 48) + 15;
    const float* rpb = p.na_rpb + ((size_t)layer * 8 + hh) * 15 * 31;
    for (int kr = 0; kr < 8; kr++) {
      const int krow = rbase + kr;
      const float* rp = rpb + (krow - gr + 7) * 31;
      for (int half = 0; half < 2; half++) {
        const int kc0 = half * 32;
        if (kc0 > khi || kc0 + 31 < klo) continue;
        const int tokb = krow * 64 + kc0;
        const u16* k0p = p.Z() + (size_t)(b * 2048 + tokb + q) * ZW + C_NK + hh * 64;
        auto bias = [&](int kl) {
          const int kc = kc0 + kl;
          const bool inw = (kc >= c0) && (kc < c0 + 16);
          const int dc = min(max(kc - qc + 15, 0), 30);
          return inw ? rp[dc] : -INFINITY;
        };
        attn_group<64, 64>(qf, o, m, l, k0p, k0p + (size_t)16 * ZW, Vbase + 256 + tokb, KEYS, scale, bias);
      }
    }
    attn_store<64>(o, l, qrow, dry);
  } else {
    const int w2 = wt - 8192;
    const int qt = w2 & 15, hh = (w2 >> 4) & 7, b = w2 >> 7;
    const int row0 = NL + b * 256 + qt * 16;
    u16* qrow = p.Z() + (size_t)(row0 + q) * ZW + C_NQ + hh * 64;
    qf[0] = *(const bf16x8*)(qrow + g * 8);
    qf[1] = *(const bf16x8*)(qrow + 32 + g * 8);
    const u16* Vbase = p.NVT() + (size_t)(b * 8 + hh) * 64 * KEYS;
    for (int kg = 0; kg < 8; kg++) {
      const int kb = kg * 32;
      const u16* k0p = p.Z() + (size_t)(NL + b * 256 + kb + q) * ZW + C_NK + hh * 64;
      attn_group<64, 64>(qf, o, m, l, k0p, k0p + (size_t)16 * ZW, Vbase + kb, KEYS, scale, nobias);
    }
    attn_store<64>(o, l, qrow, dry);
  }
}

DEV void hypre_tile(const Params& p, int layer, int tile, unsigned char* smem) {
  u16* sS = (u16*)smem;
  const int tid = tidx();
  int b, tt, ct, L, rowbase, soff;
  if (tile < 2048) {
    ct = tile & 7; tt = (tile >> 3) & 31; b = tile >> 8;
    L = SEQ; rowbase = b * 2048; soff = 256;
  } else {
    const int t2 = tile - 2048;
    ct = t2 & 7; tt = (t2 >> 3) & 3; b = t2 >> 5;
    L = CTXL; rowbase = NL + b * 256; soff = 0;
  }
  const int cg = tid & 7, tl0 = tid >> 3;
  const int c8 = ct * 64 + cg * 8;
  const float* cw = p.hy_conv_w + layer * 3 * 1536;
  const float* cbp = p.hy_conv_b + layer * 1536;
  float vv[2][8];
  __syncthreads();
#pragma unroll 1
  for (int sgrp = 0; sgrp < 3; sgrp++) {
    float wt[3][8], bs[8];
    {
      const float4 b0 = *(const float4*)(cbp + sgrp * 512 + c8), b1 = *(const float4*)(cbp + sgrp * 512 + c8 + 4);
      bs[0] = b0.x; bs[1] = b0.y; bs[2] = b0.z; bs[3] = b0.w; bs[4] = b1.x; bs[5] = b1.y; bs[6] = b1.z; bs[7] = b1.w;
#pragma unroll
      for (int j = 0; j < 3; j++) {
        const float4 w0 = *(const float4*)(cw + j * 1536 + sgrp * 512 + c8), w1 = *(const float4*)(cw + j * 1536 + sgrp * 512 + c8 + 4);
        wt[j][0] = w0.x; wt[j][1] = w0.y; wt[j][2] = w0.z; wt[j][3] = w0.w;
        wt[j][4] = w1.x; wt[j][5] = w1.y; wt[j][6] = w1.z; wt[j][7] = w1.w;
      }
    }
#pragma unroll
    for (int tk = 0; tk < 2; tk++) {
      const int tl = tl0 + tk * 32;
      const int t = tt * 64 + tl;
      float a[8];
#pragma unroll
      for (int e = 0; e < 8; e++) a[e] = bs[e];
#pragma unroll
      for (int j = 0; j < 3; j++) {
        const int ts = t + j - 1;
        if (ts >= 0 && ts < L) {
          const uint4 z = *(const uint4*)(p.Z() + (size_t)(rowbase + ts) * ZW + C_HY + sgrp * 512 + c8);
          a[0] += bflo(z.x) * wt[j][0]; a[1] += bfhi(z.x) * wt[j][1];
          a[2] += bflo(z.y) * wt[j][2]; a[3] += bfhi(z.y) * wt[j][3];
          a[4] += bflo(z.z) * wt[j][4]; a[5] += bfhi(z.z) * wt[j][5];
          a[6] += bflo(z.w) * wt[j][6]; a[7] += bfhi(z.w) * wt[j][7];
        }
      }
      if (sgrp == 0) {
#pragma unroll
        for (int e = 0; e < 8; e++) vv[tk][e] = a[e];
      } else if (sgrp == 1) {
#pragma unroll
        for (int e = 0; e < 8; e++) sS[(cg * 8 + e) * 72 + tl] = f2bf(vv[tk][e] * a[e]);
      } else {
        uint4 o;
        o.x = pack2(a[0], a[1]); o.y = pack2(a[2], a[3]); o.z = pack2(a[4], a[5]); o.w = pack2(a[6], a[7]);
        *(uint4*)(p.BRH() + (size_t)(rowbase + t) * 512 + c8) = o;
      }
    }
  }
  __syncthreads();
  for (int i = tid; i < 64 * 8; i += 256) {
    const int cc = i >> 3, t8 = i & 7;
    uint4 v = *(const uint4*)(sS + cc * 72 + t8 * 8);
    *(uint4*)(p.ST() + ((size_t)(b * 512) + ct * 64 + cc) * KEYS + soff + tt * 64 + t8 * 8) = v;
  }
}

DEV void hyena_task(const Params& p, int layer, int task, unsigned char* smem, bool dry = false) {
  constexpr int CPS = 4112;
  u16* sK = (u16*)smem;
  constexpr int SRS = 2080;
  u16* sS = sK + 4 * CPS;
  const int tid = tidx(), lane = tid & 63, w = tid >> 6, q = lane & 15, g = lane >> 4;
  const bool isctx = task >= 512;
  const int c = isctx ? task - 512 : task;
  const int L = isctx ? CTXL : SEQ;
  const int RW = isctx ? RKC : RKL;
  const int soff = isctx ? 0 : 256;
  const int rowb = isctx ? NL : 0;
  const u16* rk = p.RK() + (size_t)layer * RK_LAYER + (isctx ? (size_t)512 * RKL : 0) + (size_t)c * RW;
  __syncthreads();
  for (int i = tid; i < CPS / 8; i += 256) {
    uint4 v = make_uint4(0, 0, 0, 0);
    if (i * 8 < RW) v = *(const uint4*)(rk + i * 8);
    *(uint4*)(sK + i * 8) = v;
  }
  for (int i = tid; i < 8 * (L / 8); i += 256) {
    const int bb = i / (L / 8), i8 = i % (L / 8);
    *(uint4*)(sS + bb * SRS + i8 * 8) = *(const uint4*)(p.ST() + ((size_t)bb * 512 + c) * KEYS + soff + i8 * 8);
  }
  __syncthreads();
  const int n4 = RW / 4;
  for (int i = tid; i < 3 * n4; i += 256) {
    const int mcp = 1 + i / n4, i4 = i % n4;
    union { uint2 v; u16 s[4]; } t;
#pragma unroll
    for (int e = 0; e < 4; e++) t.s[e] = sK[i4 * 4 + mcp + e];
    *(uint2*)(sK + mcp * CPS + i4 * 4) = t.v;
  }
  __syncthreads();
  const int Dm = L - 1;
  const int ngrp = L / 128;
  const u16* sp = sS + (q & 7) * SRS + g * 8;
#define HY_LD(dst, o_)                                                     \
  {                                                                        \
    const int o__ = (o_);                                                  \
    const int mcp__ = o__ & 3, base__ = o__ & ~3;                          \
    union { bf16x8 v; uint2 u[2]; } f__;                                   \
    f__.u[0] = *(const uint2*)(sK + mcp__ * CPS + base__);                 \
    f__.u[1] = *(const uint2*)(sK + mcp__ * CPS + base__ + 4);             \
    dst = f__.v;                                                           \
  }
  for (int grp = w; grp < ngrp; grp += 4) {
    f32x4 acc[8];
#pragma unroll
    for (int ti = 0; ti < 8; ti++) acc[ti] = f32x4{0.f, 0.f, 0.f, 0.f};
    const int tb = grp * 128;
    const int obase = Dm - tb - q + g * 8;
    bf16x8 A[8];
#pragma unroll
    for (int ti = 2; ti < 8; ti++) HY_LD(A[ti], obase - 16 * ti);
#pragma unroll 1
    for (int s0 = 0; s0 < L; s0 += 128) {
#pragma unroll
      for (int u = 0; u < 4; u++) {
        const int sc = s0 + 32 * u;
        bf16x8 bfrag = *(const bf16x8*)(sp + sc);
        if (q >= 8) bfrag = bf16x8{0, 0, 0, 0, 0, 0, 0, 0};
        HY_LD(A[(8 - 2 * u) & 7], obase + sc);
        HY_LD(A[(9 - 2 * u) & 7], obase - 16 + sc);
#pragma unroll
        for (int ti = 0; ti < 8; ti++)
          acc[ti] = __builtin_amdgcn_mfma_f32_16x16x32_bf16(A[(ti + 8 - 2 * u) & 7], bfrag, acc[ti], 0, 0, 0);
      }
    }
    if (q < 8) {
#pragma unroll
      for (int ti = 0; ti < 8; ti++)
#pragma unroll
        for (int j = 0; j < 4; j++) {
          const int t = tb + ti * 16 + g * 4 + j;
          u16* dst = p.BRH() + (size_t)(rowb + q * L + t) * 512 + c;
          const u16 nv = f2bf(bf2f(*dst) * acc[ti][j]);
          if (!dry) *dst = nv;
        }
    }
  }
#undef HY_LD
}

DEV void s5_decode(int wt, int& b, int& g, int& chunk, int& row0) {
  chunk = wt % NCH;
  const int bg = wt / NCH;
  g = bg & 31;
  b = bg >> 5;
  row0 = chunk < 8 ? NL + b * 256 + chunk * 32 : b * 2048 + (chunk - 8) * 32;
}

using f32x16 = __attribute__((ext_vector_type(16))) float;
template <int dir>
DEV void s5_p1_dir(const Params& p, int layer, int b, int g, int chunk, int c, int hh, const bf16x8& ua) {
  const int ldg = (layer * 2 + dir) * 32 + g;
  const float* sp = p.S5P() + (size_t)ldg * 2304;
  float Lr[2][4], Li[2][4], qr[2], qi[2];
#pragma unroll
  for (int st = 0; st < 2; st++) {
    const float lr = sp[st * 32 + c], li = sp[64 + st * 32 + c];
    const float tr = lr * lr - li * li, ti = 2.f * lr * li;
    qr[st] = tr * tr - ti * ti;
    qi[st] = 2.f * tr * ti;
    f32x16 zr, zi;
#pragma unroll
    for (int i = 0; i < 16; i++) { zr[i] = 0.f; zi[i] = 0.f; }
    const bf16x8 bre = *(const bf16x8*)(p.S5PB() + ((size_t)ldg * 128 + st * 32 + c) * 16 + hh * 8);
    const bf16x8 bim = *(const bf16x8*)(p.S5PB() + ((size_t)ldg * 128 + 64 + st * 32 + c) * 16 + hh * 8);
    const f32x16 bur = __builtin_amdgcn_mfma_f32_32x32x16_bf16(ua, bre, zr, 0, 0, 0);
    const f32x16 bui = __builtin_amdgcn_mfma_f32_32x32x16_bf16(ua, bim, zi, 0, 0, 0);
#pragma unroll
    for (int sl = 0; sl < 4; sl++) {
      float xr = 0.f, xi = 0.f;
#pragma unroll
      for (int jj = 0; jj < 4; jj++) {
        const int r = sl * 4 + (dir == 0 ? jj : 3 - jj);
        const float nr = lr * xr - li * xi + bur[r];
        const float ni = lr * xi + li * xr + bui[r];
        xr = nr; xi = ni;
      }
      Lr[st][sl] = xr; Li[st][sl] = xi;
    }
  }
  float cr[2] = {0.f, 0.f}, ci[2] = {0.f, 0.f};
#pragma unroll
  for (int ss = 0; ss < 8; ss++) {
    const int sgm = dir == 0 ? ss : 7 - ss;
    const int sl = sgm >> 1;
    const int src = c + 32 * (sgm & 1);
#pragma unroll
    for (int st = 0; st < 2; st++) {
      const float ar = __shfl(Lr[st][sl], src);
      const float ai = __shfl(Li[st][sl], src);
      const float nr = qr[st] * cr[st] - qi[st] * ci[st] + ar;
      const float ni = qr[st] * ci[st] + qi[st] * cr[st] + ai;
      cr[st] = nr; ci[st] = ni;
    }
  }
  if (hh == 0) {
    float2* F = (float2*)p.S5F() + ((size_t)((b * 32 + g) * 2 + dir) * NCH + chunk) * 64;
    F[c] = make_float2(cr[0], ci[0]);
    F[32 + c] = make_float2(cr[1], ci[1]);
  }
}

DEV void s5_pass1_wave(const Params& p, int layer, int wt, unsigned char* smem) {
  const int lane = tidx() & 63, c = lane & 31, hh = lane >> 5;
  int b, g, chunk, row0;
  s5_decode(wt, b, g, chunk, row0);
  const bf16x8 ua = *(const bf16x8*)(p.Z() + (size_t)(row0 + c) * ZW + C_U + g * 16 + hh * 8);
  s5_p1_dir<0>(p, layer, b, g, chunk, c, hh, ua);
  __builtin_amdgcn_sched_barrier(0);
  s5_p1_dir<1>(p, layer, b, g, chunk, c, hh, ua);
  __builtin_amdgcn_sched_barrier(0);
}

DEV void s5_prefix_phase(const Params& p, const int layer) {
  const int tx = tidx512();
  const int lane = tx & 63;
  const int nwv = gridDim.x * 8;
  for (int wt = blockIdx.x * 8 + (tx >> 6); wt < NB * 32 * 2; wt += nwv) {
    const int dir = wt & 1, g = (wt >> 1) & 31, b = wt >> 6;
    const float* sp = p.S5P() + (size_t)((layer * 2 + dir) * 32 + g) * 2304;
    const float cr = sp[128 + lane], ci = sp[192 + lane];
    float2* F = (float2*)p.S5F() + ((size_t)((b * 32 + g) * 2 + dir) * NCH) * 64 + lane;
    float xr = 0.f, xi = 0.f;
#pragma unroll 1
    for (int j0 = 0; j0 < NCH; j0 += 8) {
      float2 fb[8];
      int cjs[8];
#pragma unroll
      for (int jj = 0; jj < 8; jj++) {
        const int j = j0 + jj;
        cjs[jj] = dir == 0 ? j : (j < 8 ? 7 - j : 79 - j);
        fb[jj] = F[(size_t)cjs[jj] * 64];
      }
#pragma unroll
      for (int jj = 0; jj < 8; jj++) {
        F[(size_t)cjs[jj] * 64] = make_float2(xr, xi);
        const float nr = cr * xr - ci * xi + fb[jj].x;
        const float ni = cr * xi + ci * xr + fb[jj].y;
        xr = nr; xi = ni;
      }
    }
  }
}

template <int dir>
DEV void s5_p2_dir(const Params& p, int layer, int b, int g, int chunk, int lane, const bf16x8& ua, u16* XS) {
  const int c = lane & 31, hh = lane >> 5;
  const int ldg = (layer * 2 + dir) * 32 + g;
  const float* sp = p.S5P() + (size_t)ldg * 2304;
  const float2* Fin = (const float2*)p.S5F() + ((size_t)((b * 32 + g) * 2 + dir) * NCH + chunk) * 64;
#pragma unroll
  for (int st = 0; st < 2; st++) {
    const int pst = st * 32 + c;
    const float2 fin = Fin[pst];
    float cr_ = fin.x, ci_ = fin.y;
    const float lr = sp[pst], li = sp[64 + pst];
    const float p2r = lr * lr - li * li, p2i = 2.f * lr * li;
    const float p3r = p2r * lr - p2i * li, p3i = p2r * li + p2i * lr;
    const float p4r = p2r * p2r - p2i * p2i, p4i = 2.f * p2r * p2i;
    f32x16 zr, zi;
#pragma unroll
    for (int i = 0; i < 16; i++) { zr[i] = 0.f; zi[i] = 0.f; }
    const bf16x8 bre = *(const bf16x8*)(p.S5PB() + ((size_t)ldg * 128 + pst) * 16 + hh * 8);
    const bf16x8 bim = *(const bf16x8*)(p.S5PB() + ((size_t)ldg * 128 + 64 + pst) * 16 + hh * 8);
    f32x16 vr = __builtin_amdgcn_mfma_f32_32x32x16_bf16(ua, bre, zr, 0, 0, 0);
    f32x16 vi = __builtin_amdgcn_mfma_f32_32x32x16_bf16(ua, bim, zi, 0, 0, 0);
    float Lr[4], Li[4];
#pragma unroll
    for (int sl = 0; sl < 4; sl++) {
      float ar = 0.f, ai = 0.f;
#pragma unroll
      for (int jj = 0; jj < 4; jj++) {
        const int r = sl * 4 + (dir == 0 ? jj : 3 - jj);
        const float nr = lr * ar - li * ai + vr[r];
        const float ni = lr * ai + li * ar + vi[r];
        ar = nr; ai = ni;
        vr[r] = ar; vi[r] = ai;
      }
      Lr[sl] = ar; Li[sl] = ai;
    }
    float Cr[4], Ci[4];
#pragma unroll
    for (int sl = 0; sl < 4; sl++) { Cr[sl] = 0.f; Ci[sl] = 0.f; }
#pragma unroll
    for (int ss = 0; ss < 8; ss++) {
      const int sgm = dir == 0 ? ss : 7 - ss;
      const int sl = sgm >> 1;
      const bool mine = hh == (sgm & 1);
      const int src = c + 32 * (sgm & 1);
      const float ar = __shfl(Lr[sl], src);
      const float ai = __shfl(Li[sl], src);
      Cr[sl] = mine ? cr_ : Cr[sl];
      Ci[sl] = mine ? ci_ : Ci[sl];
      const float nr = p4r * cr_ - p4i * ci_ + ar;
      const float ni = p4r * ci_ + p4i * cr_ + ai;
      cr_ = nr; ci_ = ni;
    }
#pragma unroll
    for (int sl = 0; sl < 4; sl++) {
#pragma unroll
      for (int jj = 0; jj < 4; jj++) {
        const int r = sl * 4 + jj;
        const int stp = dir == 0 ? jj : 3 - jj;
        const float wr = stp == 0 ? lr : (stp == 1 ? p2r : (stp == 2 ? p3r : p4r));
        const float wi = stp == 0 ? li : (stp == 1 ? p2i : (stp == 2 ? p3i : p4i));
        const float xr_ = vr[r] + wr * Cr[sl] - wi * Ci[sl];
        const float xi_ = vi[r] + wr * Ci[sl] + wi * Cr[sl];
        const int t = jj + 8 * sl + 4 * hh;
        XS[t * 264 + dir * 128 + pst] = f2bf(xr_);
        XS[t * 264 + dir * 128 + 64 + pst] = f2bf(xi_);
      }
    }
  }
}

DEV void s5_pass2_block(const Params& p, int layer, int blk, unsigned char* smem, bool dry = false) {
  const int tid = tidx(), lane = tid & 63, w = tid >> 6, q = lane & 15, gq = lane >> 4;
  u16* XS = (u16*)smem + w * (32 * 264);
  int b, g, chunk, row0;
  s5_decode(blk * 4 + w, b, g, chunk, row0);
  __syncthreads();
  {
    const bf16x8 ua = *(const bf16x8*)(p.Z() + (size_t)(row0 + (lane & 31)) * ZW + C_U + g * 16 + (lane >> 5) * 8);
    s5_p2_dir<0>(p, layer, b, g, chunk, lane, ua, XS);
    __builtin_amdgcn_sched_barrier(0);
    s5_p2_dir<1>(p, layer, b, g, chunk, lane, ua, XS);
    __builtin_amdgcn_sched_barrier(0);
  }
  __syncthreads();
  f32x4 y0 = {0.f, 0.f, 0.f, 0.f}, y1 = {0.f, 0.f, 0.f, 0.f};
#pragma unroll
  for (int ks = 0; ks < 8; ks++) {
    union { bf16x8 v; unsigned u[4]; } cf;
    cf.v = *(const bf16x8*)(p.S5PC() + ((size_t)(layer * 32 + g) * 16 + q) * 256 + ks * 32 + gq * 8);
    bf16x8 x0 = *(const bf16x8*)(XS + q * 264 + ks * 32 + gq * 8);
    bf16x8 x1 = *(const bf16x8*)(XS + (16 + q) * 264 + ks * 32 + gq * 8);
    y0 = __builtin_amdgcn_mfma_f32_16x16x32_bf16(cf.v, x0, y0, 0, 0, 0);
    y1 = __builtin_amdgcn_mfma_f32_16x16x32_bf16(cf.v, x1, y1, 0, 0, 0);
  }
  const float4 d4 = *(const float4*)(p.s5_d + layer * 512 + g * 16 + gq * 4);
  const float dd[4] = {d4.x, d4.y, d4.z, d4.w};
#pragma unroll
  for (int mt = 0; mt < 2; mt++) {
    u16* zp = p.Z() + (size_t)(row0 + mt * 16 + q) * ZW + C_U + g * 16 + gq * 4;
    uint2 uv = *(const uint2*)zp;
    const float uf[4] = {bflo(uv.x), bfhi(uv.x), bflo(uv.y), bfhi(uv.y)};
    float r[4];
#pragma unroll
    for (int j = 0; j < 4; j++) {
      float y = (mt == 0 ? y0[j] : y1[j]) + dd[j] * uf[j];
      float inner = 0.7978845608028654f * (y + 0.044715f * y * y * y);
      r[j] = 0.5f * y * (1.f + tanhf(inner));
    }
    uint2 o;
    o.x = pack2(r[0], r[1]);
    o.y = pack2(r[2], r[3]);
    __syncthreads();
    if (!dry) *(uint2*)zp = o;
  }
}

DEV int xcd_slot64(int v) { return ((v >> 4) << 1) | (v & 1); }
DEV int mla_task_remap(int v) { return (((v >> 1) & 7) << 6) | xcd_slot64(v); }
DEV int na_task_remap(int u) {
  const int v = u & 511, i = u >> 9;
  const int c = (((v >> 1) & 7) << 8) | (i << 6) | xcd_slot64(v);
  const int bh = c >> 5, gr = c & 31;
  return ((bh >> 3) << 8) | (gr << 3) | (bh & 7);
}

#ifndef PH_MASK
#define PH_MASK 0xFFFF
#endif
#define PHON(k) ((PH_MASK >> (k)) & 1)
#ifndef SUB_MASK
#define SUB_MASK 0xFF
#endif
#define SUBON(k) ((SUB_MASK >> (k)) & 1)
#ifndef REPEAT_SUB
#define REPEAT_SUB 0xFF
#endif
#define DRYON(k) (!dry || ((REPEAT_SUB >> (k)) & 1))
DEV void run_phase(const Params& p, const int ph, unsigned char* smem_all, const bool dry = false) {
  const int hb = __builtin_amdgcn_readfirstlane((int)(threadIdx.x >> 8));
  unsigned char* smem = smem_all + hb * SMEM_BYTES;
  const int bid = blockIdx.x * 2 + hb, nb = gridDim.x * 2;
  if (ph == 0) {
    if (!PHON(13)) return;
    for (int t = bid; t < 288 + WF_TILES; t += nb) {
      if (t < 288) mods_task(p, t, smem);
      else wconv_ffn(p, 0, 0, t - 288, smem);
    }
    return;
  }
  if (ph == 1) {
    if (!PHON(14)) return;
    for (int r = bid * 4 + (tidx() >> 6); r < NT; r += nb * 4) norm1_row(p, r);
    return;
  }
  const int layer = (ph - 2) / 13, k = (ph - 2) % 13;
  const bool last = layer == 1;
  const int MT_ALL = NT / 128, MT_LAT = NL / 128;
  switch (k) {
    case 0: if (PHON(0)) {
      const int MT = MT_ALL / 2, ntile = MT * 22;
      for (int t = blockIdx.x; t < ntile; t += gridDim.x) ffn_in_tile8(p, 0, t, MT, smem_all);
      __syncthreads();
    } break;
    case 1: if (PHON(1)) {
      const int MT = MT_ALL / 2, ntile = MT * 4;
      const u16* W = p.WF() + WF_OUT;
      for (int t = blockIdx.x; t < ntile; t += gridDim.x) f32out_tile8<FH>(p, p.HID(), W, t, MT, smem_all);
      __syncthreads();
      if (layer == 0) {
        const int nlate = max(0, ntile - (int)gridDim.x);
        if ((int)blockIdx.x >= nlate) {
          const int vb = ((int)blockIdx.x - nlate) * 2 + hb, nvb = ((int)gridDim.x - nlate) * 2;
          for (int t = vb; t < 576 + 32 + WM_TILES; t += nvb) {
            if (t < 576) hyfilt_task(p, t, smem);
            else if (t < 608) s5pre_task(p, t - 576);
            else wconv_mixer(p, 0, t - 608, smem);
          }
        }
      }
    } break;
    case 2: if (PHON(2)) {
      for (int r = bid * 4 + (tidx() >> 6); r < NT; r += nb * 4) resid_row(p, r, layer, 0.5f, 2, 1, true, layer, 2, 3, 4, dry, layer == 0);
    } break;
    case 3: if (PHON(3)) {
      const int MT = MT_ALL / 2, ntile = MT * 17;
      for (int t = blockIdx.x; t < ntile; t += gridDim.x) inproj_tile8(p, t, MT, smem_all);
      __syncthreads();
    } break;
    case 4: if (PHON(4)) {
      const int n_hp = last ? 2048 : 2304;
      const int n_s5 = (NB * 32 * NCH) / 4;
      const int n_mn = NT / 4;
      const int total = n_hp + n_s5 + n_mn;
      for (int t = bid; t < total; t += nb) {
        if (t < n_hp) { if (DRYON(0)) hypre_tile(p, layer, t, smem); }
        else if (t < n_hp + n_s5) { if (DRYON(1)) s5_pass1_wave(p, layer, (t - n_hp) * 4 + (tidx() >> 6), smem); }
        else if (DRYON(2)) mla_norm_row(p, layer, (t - n_hp - n_s5) * 4 + (tidx() >> 6), dry);
      }
    } break;
    case 5: if (PHON(5)) {
      const int n_hy = last ? 512 : 1024;
      const int n_na = last ? 2048 : 2304;
      const int n_s5 = (NB * 32 * NCH) / 4;
      const int n_kv = MT_ALL * 8;
      const int MTq = last ? MT_LAT : MT_ALL;
      const int n_q = MTq * 6;
      const int total = n_hy + n_na + n_s5 + n_kv + n_q;
      for (int t = bid; t < total; t += nb) {
        int u = t;
        if (u < n_hy) { if (SUBON(0) && DRYON(0)) hyena_task(p, layer, u, smem, dry); continue; }
        u -= n_hy;
        if (u < n_na) { if (SUBON(1) && DRYON(1)) na_attn_block(p, layer, u < 2048 ? na_task_remap(u) : u, smem, dry); continue; }
        u -= n_na;
        if (u < n_s5) {
          const int chunk0 = (u * 4) % NCH;
          if (last && chunk0 < 8) continue;
          if (SUBON(2) && DRYON(2)) s5_pass2_block(p, layer, u, smem, dry);
          continue;
        }
        u -= n_s5;
        if (u < n_kv) { if (SUBON(3) && DRYON(3)) kvup_tile(p, layer, u, MT_ALL, smem); continue; }
        u -= n_kv;
        if (SUBON(4) && DRYON(4)) qup_tile(p, layer, u, MTq, smem);
      }
    } break;
    case 6: if (PHON(6)) {
      const int n_at = last ? 512 : 576;
      const int MT = last ? MT_LAT : MT_ALL;
      const int n_gl = MT * 8;
      const int total = n_at + n_gl;
      {
        const int MTg = MT / 2, ngate = MTg * 16;
        for (int t = blockIdx.x; t < ngate; t += gridDim.x) gate_tile8(p, t, MTg, smem_all);
        __syncthreads();
      }
      for (int t = bid; t < total; t += nb) {
        if (t < n_at) mla_attn_block(p, t < 512 ? mla_task_remap(t) : t, smem, dry);
        else glu_tile(p, layer, t - n_at, MT, smem);
      }
    } break;
    case 7: if (PHON(7)) {
      const int MT = last ? MT_LAT : MT_ALL, ntile = MT * 8;
      for (int t = bid; t < ntile; t += nb) merge_tile(p, layer, t, MT, smem);
    } break;
    case 8: if (PHON(8)) {
      const int MT = (last ? MT_LAT : MT_ALL) / 2, ntile = MT * 4;
      const u16* W = p.WM() + WM_OUT;
      for (int t = blockIdx.x; t < ntile; t += gridDim.x) f32out_tile8<D>(p, p.M(), W, t, MT, smem_all);
      __syncthreads();
      {
        const int nlate = max(0, ntile - (int)gridDim.x);
        if ((int)blockIdx.x >= nlate) {
          const int vb = ((int)blockIdx.x - nlate) * 2 + hb, nvb = ((int)gridDim.x - nlate) * 2;
          for (int t = vb; t < WF_TILES; t += nvb) wconv_ffn(p, layer, 1, t, smem);
        }
      }
    } break;
    case 9: if (PHON(9)) {
      const int nr = last ? NL : NT;
      for (int r = bid * 4 + (tidx() >> 6); r < nr; r += nb * 4) resid_row(p, r, layer, 1.0f, 5, 3, true, layer, 4, 6, 7, dry);
    } break;
    case 10: if (PHON(10)) {
      const int MT = (last ? MT_LAT : MT_ALL) / 2, ntile = MT * 22;
      for (int t = blockIdx.x; t < ntile; t += gridDim.x) ffn_in_tile8(p, 1, t, MT, smem_all);
      __syncthreads();
    } break;
    case 11: if (PHON(11)) {
      const int MT = (last ? MT_LAT : MT_ALL) / 2, ntile = MT * 4;
      const u16* W = p.WF() + WF_ELEMS + WF_OUT;
      for (int t = blockIdx.x; t < ntile; t += gridDim.x) f32out_tile8<FH>(p, p.HID(), W, t, MT, smem_all);
      __syncthreads();
      if (!last) {
        const int nlate = max(0, ntile - (int)gridDim.x);
        if ((int)blockIdx.x >= nlate) {
          const int vb = ((int)blockIdx.x - nlate) * 2 + hb, nvb = ((int)gridDim.x - nlate) * 2;
          for (int t = vb; t < WM_TILES + WF_TILES; t += nvb) {
            if (t < WM_TILES) wconv_mixer(p, 1, t, smem);
            else wconv_ffn(p, 1, 0, t - WM_TILES, smem);
          }
        }
      }
    } break;
    case 12: if (PHON(12)) {
      const int nr = last ? NL : NT;
      for (int r = bid * 4 + (tidx() >> 6); r < nr; r += nb * 4) resid_row(p, r, layer, 0.5f, 8, 5, !last, layer + 1, 0, 0, 1, dry);
    } break;
  }
}


#define XB_TMO      128
#define XB_XCNT(j)  (256  + 64 * (j))
#define XB_XSUB(j)  (1280 + 64 * (j))
#define XB_XGEN(j)  (2304 + 64 * (j))
#define XB_TOP      3328
#define XB_TOPGEN   3392
#define XCD_BAR_WORDS 3456
#define XB_SPIN_CAP (1u << 20)
#define LAS __attribute__((address_space(3)))
__device__ __forceinline__ unsigned xb_ld(unsigned* p)              { return __hip_atomic_load(p, __ATOMIC_RELAXED, __HIP_MEMORY_SCOPE_AGENT); }
__device__ __forceinline__ unsigned xb_add(unsigned* p, unsigned v) { return __hip_atomic_fetch_add(p, v, __ATOMIC_RELAXED, __HIP_MEMORY_SCOPE_AGENT); }
__device__ __forceinline__ unsigned xb_xcc_id() { return (unsigned)__builtin_amdgcn_s_getreg((3 << 11) | 20) & 0xFu; }
#define XB_SPIN(cond, bar) do { unsigned _sp = 0; while (cond) { __builtin_amdgcn_s_sleep(1); \
    if ((++_sp & 255u) == 0u) { if (xb_ld(&(bar)[XB_TMO])) break; if (_sp > XB_SPIN_CAP) { atomicAdd(&(bar)[XB_TMO], 1u); break; } } } } while (0)
struct XcdBarrier { unsigned* bar; unsigned x; volatile LAS unsigned* st; };
__device__ __forceinline__ XcdBarrier xcd_barrier_post(unsigned* bar, volatile LAS unsigned* st) {
    XcdBarrier b; b.bar = bar; b.x = xb_xcc_id(); b.st = st;
    if (threadIdx.x == 0) (void)xb_add(&bar[XB_XCNT(b.x)], 1u);
    return b;
}
__device__ __forceinline__ void xcd_barrier_complete(unsigned* bar, unsigned x, unsigned& nloc, unsigned& nx) {
    const unsigned G = gridDim.x * gridDim.y * gridDim.z;
    unsigned sum, cnt, mine, sp = 0u;
    for (;;) {
        sum = 0u; cnt = 0u; mine = 0u;
#pragma unroll
        for (unsigned j = 0; j < 16; ++j) { const unsigned c = xb_ld(&bar[XB_XCNT(j)]); sum += c; cnt += (c > 0u) ? 1u : 0u; mine = (j == x) ? c : mine; }
        if (sum == G) break;
        __builtin_amdgcn_s_sleep(1);
        if ((++sp & 255u) == 0u) { if (xb_ld(&bar[XB_TMO])) break; if (sp > XB_SPIN_CAP) { atomicAdd(&bar[XB_TMO], 1u); break; } }
    }
    nloc = mine > 0u ? mine : 1u; nx = cnt > 0u ? cnt : 1u;
}
__device__ __forceinline__ void xcd_barrier(const XcdBarrier& b) {
    asm volatile("s_waitcnt vmcnt(0)" ::: "memory");
    __syncthreads();
    if (threadIdx.x == 0) {
        unsigned* bar = b.bar;
        __builtin_amdgcn_s_waitcnt(0);
        unsigned nloc = b.st[0], nx = b.st[1];
        if (nloc == 0u) { xcd_barrier_complete(bar, b.x, nloc, nx); b.st[0] = nloc; b.st[1] = nx; }
        const unsigned old = xb_add(&bar[XB_XSUB(b.x)], 1u);
        const unsigned gen = old / nloc;
        if (old + 1u == (gen + 1u) * nloc) {
            __builtin_amdgcn_fence(__ATOMIC_RELEASE, "agent");
            asm volatile("s_waitcnt vmcnt(0)" ::: "memory");
            const unsigned og = xb_add(&bar[XB_TOP], 1u);
            const unsigned tg = og / nx;
            if (og + 1u == (tg + 1u) * nx) xb_add(&bar[XB_TOPGEN], 1u);
            else XB_SPIN(xb_ld(&bar[XB_TOPGEN]) == tg, bar);
            __builtin_amdgcn_fence(__ATOMIC_ACQUIRE, "agent");
            xb_add(&bar[XB_XGEN(b.x)], 1u);
            asm volatile("s_waitcnt vmcnt(0)" ::: "memory");
        } else {
            XB_SPIN(xb_ld(&bar[XB_XGEN(b.x)]) == gen, bar);
            __builtin_amdgcn_fence(__ATOMIC_ACQUIRE, "agent");
            asm volatile("s_waitcnt vmcnt(0)" ::: "memory");
        }
    }
    __syncthreads();
}

constexpr int N_PHASES = 2 + 26;

__global__ void __launch_bounds__(512, 2) mega_kernel(Params p, int ph_lo, int ph_hi) {
  __shared__ __attribute__((aligned(16))) unsigned char smem[SMEM_TOTAL];
  uint4* xbw = (uint4*)(smem + 2 * SMEM_BYTES);
  if (threadIdx.x == 0) *xbw = make_uint4(0u, 0u, 0u, 0u);
  __syncthreads();
  XcdBarrier xb = xcd_barrier_post(p.bar(), (volatile LAS unsigned*)xbw);
  if (ph_lo < 0) cg::this_grid().sync();
#define RP(i) run_phase(p, (i), smem); xcd_barrier(xb);
  RP(0) RP(1) RP(2) RP(3) RP(4) RP(5) RP(6)
  s5_prefix_phase(p, 0); xcd_barrier(xb);
  RP(7) RP(8) RP(9) RP(10) RP(11) RP(12) RP(13) RP(14)
  RP(15) RP(16) RP(17) RP(18) RP(19)
  s5_prefix_phase(p, 1); xcd_barrier(xb);
  RP(20) RP(21) RP(22) RP(23) RP(24) RP(25) RP(26)
  run_phase(p, 27, smem);
#undef RP
}

static inline size_t align_up(size_t v) { return (v + 255) & ~(size_t)255; }

extern "C" void kernel_launch(void* const* d_in, const int* in_sizes, int n_in, void* d_out, int out_size, void* d_ws,
                              size_t ws_size, hipStream_t stream) {
  Params p{};
  const float** pp = (const float**)&p;
  for (int i = 0; i < 37; i++) pp[i] = (const float*)d_in[i];
  p.out = (float*)d_out;
  p.ws = (unsigned char*)d_ws;
  if (WS_TOTAL > ws_size) { fprintf(stderr, "workspace too small: need %zu have %zu\n", (size_t)WS_TOTAL, ws_size); return; }

  static int grid_blocks = 0;
  if (!grid_blocks) {
    int dev = 0, cus = 0, per_cu = 0;
    hipGetDevice(&dev);
    hipDeviceGetAttribute(&cus, hipDeviceAttributeMultiprocessorCount, dev);
    hipOccupancyMaxActiveBlocksPerMultiprocessor(&per_cu, mega_kernel, 512, 0);
    if (per_cu > 1) per_cu = 1;
    grid_blocks = cus * per_cu;
  }
  hipMemsetAsync(p.ws + OFF_BAR, 0, (size_t)XCD_BAR_WORDS * 4, stream);
  int lo = 0, hi = N_PHASES;
  void* args[] = {&p, &lo, &hi};
  hipError_t e = hipLaunchCooperativeKernel((void*)mega_kernel, dim3(grid_blocks), dim3(512), args, 0, stream);
  if (e != hipSuccess) fprintf(stderr, "cooperative launch failed: %s (grid %d)\n", hipGetErrorString(e), grid_blocks);
}
```
